# Optimizing an MI355X kernel written in HIP

```python
import jax, jax.numpy as jnp
from jax import lax
import numpy as np

D_MODEL = 1024
BATCH = 4
SEQ = 4096
DEPTH = 1

MLA_HEADS = 4
V_HEAD_DIM = D_MODEL // (2 * MLA_HEADS)
QK_NOPE_DIM = V_HEAD_DIM
QK_ROPE_DIM = V_HEAD_DIM // 2
Q_LORA_RANK = D_MODEL // 4
KV_LORA_RANK = D_MODEL // 8
MLA_WIDTH = MLA_HEADS * V_HEAD_DIM
POOL_WIDTH = D_MODEL - MLA_WIDTH
POOL_WINDOWS = (2, 4, 8, 16)
POOL_GROUPS = len(POOL_WINDOWS)
POOL_CH = POOL_WIDTH // POOL_GROUPS
IN_PROJ_DIM = Q_LORA_RANK + KV_LORA_RANK + QK_ROPE_DIM + POOL_WIDTH
D_FF = ((8 * D_MODEL // 3 + 255) // 256) * 256
N_MEM = 256
MEM_HEADS = 4
MEM_HEAD_DIM = D_MODEL // MEM_HEADS
ROPE_BASE = 10000.0
RMS_EPS = 1e-6
BLOCK_Q = 128

kernel_name = "hymba_mla_pool_macaron_memxattn"


def rmsnorm(x, g):
    xf = x.astype(jnp.float32)
    y = xf * lax.rsqrt(jnp.mean(xf * xf, axis=-1, keepdims=True) + RMS_EPS)
    return (y * g.astype(jnp.float32)).astype(x.dtype)


def swiglu(x, w_gate, w_up, w_down):
    return (jax.nn.silu(x @ w_gate) * (x @ w_up)) @ w_down


def rope(x, positions):
    d = x.shape[-1]
    freqs = 1.0 / (ROPE_BASE ** (jnp.arange(0, d, 2, dtype=jnp.float32) / d))
    ang = positions.astype(jnp.float32)[..., None] * freqs
    cos = jnp.cos(ang)[:, :, None, :]
    sin = jnp.sin(ang)[:, :, None, :]
    xf = x.astype(jnp.float32)
    x1, x2 = xf[..., : d // 2], xf[..., d // 2:]
    out = jnp.concatenate([x1 * cos - x2 * sin, x1 * sin + x2 * cos], axis=-1)
    return out.astype(x.dtype)


def causal_block_attention(q, k, v, scale):
    B, S, H, Dqk = q.shape
    nblk = S // BLOCK_Q
    qb = q.reshape(B, nblk, BLOCK_Q, H, Dqk).transpose(1, 0, 2, 3, 4)
    key_pos = jnp.arange(S)

    def one_block(args):
        qi, i = args
        s = jnp.einsum('bqhd,bkhd->bhqk', qi, k).astype(jnp.float32) * scale
        q_pos = i * BLOCK_Q + jnp.arange(BLOCK_Q)
        mask = key_pos[None, :] <= q_pos[:, None]
        s = jnp.where(mask[None, None], s, -jnp.inf)
        p = jax.nn.softmax(s, axis=-1).astype(v.dtype)
        return jnp.einsum('bhqk,bkhd->bqhd', p, v)

    out = lax.map(one_block, (qb, jnp.arange(nblk)))
    return out.transpose(1, 0, 2, 3, 4).reshape(B, S, H, v.shape[-1])


def mla_group(c_q, c_kv, k_rope, positions, q_norm, w_q_up, kv_norm, w_kv_up):
    B, S, _ = c_q.shape
    q = (rmsnorm(c_q, q_norm) @ w_q_up).reshape(B, S, MLA_HEADS, QK_NOPE_DIM + QK_ROPE_DIM)
    q_nope, q_pe = q[..., :QK_NOPE_DIM], q[..., QK_NOPE_DIM:]
    q_pe = rope(q_pe, positions)
    kv = (rmsnorm(c_kv, kv_norm) @ w_kv_up).reshape(B, S, MLA_HEADS, QK_NOPE_DIM + V_HEAD_DIM)
    k_nope, v = kv[..., :QK_NOPE_DIM], kv[..., QK_NOPE_DIM:]
    k_pe = rope(k_rope[:, :, None, :], positions)
    k_pe = jnp.broadcast_to(k_pe, (B, S, MLA_HEADS, QK_ROPE_DIM))
    q_full = jnp.concatenate([q_nope, q_pe], axis=-1)
    k_full = jnp.concatenate([k_nope, k_pe], axis=-1)
    scale = (QK_NOPE_DIM + QK_ROPE_DIM) ** -0.5
    o = causal_block_attention(q_full, k_full, v, scale)
    return o.reshape(B, S, MLA_WIDTH)


def pool_group(z, pool_w, pool_scale):
    B, S, _ = z.shape
    zg = z.reshape(B, S, POOL_GROUPS, POOL_CH)
    cs = jnp.cumsum(zg.astype(jnp.float32), axis=1)
    cs = jnp.pad(cs, ((0, 0), (1, 0), (0, 0), (0, 0)))
    t1 = jnp.arange(1, S + 1, dtype=jnp.float32)
    pooled = []
    for g, w in enumerate(POOL_WINDOWS):
        hi = cs[:, 1:, g]
        lo = jnp.pad(cs[:, : S + 1 - w, g], ((0, 0), (w - 1, 0), (0, 0)))
        count = jnp.minimum(t1, float(w))[None, :, None]
        pooled.append((hi - lo) / count)
    mean = jnp.stack(pooled, axis=2).astype(z.dtype)
    y = jnp.einsum('bsgc,gcd->bsgd', mean - zg, pool_w).reshape(B, S, POOL_WIDTH)
    return y * pool_scale


def memory_cross_attention(hn, memn, w_mq, w_mkv, w_mo):
    B, S, _ = hn.shape
    q = (hn @ w_mq).reshape(B, S, MEM_HEADS, MEM_HEAD_DIM)
    kv = (memn @ w_mkv).reshape(B, N_MEM, 2, MEM_HEADS, MEM_HEAD_DIM)
    k, v = kv[:, :, 0], kv[:, :, 1]
    s = jnp.einsum('bshd,bmhd->bhsm', q, k).astype(jnp.float32) * (MEM_HEAD_DIM ** -0.5)
    p = jax.nn.softmax(s, axis=-1).astype(v.dtype)
    o = jnp.einsum('bhsm,bmhd->bshd', p, v).reshape(B, S, D_MODEL)
    return o @ w_mo


def setup_inputs(seed: int = 0) -> dict:
    key = jax.random.key(seed)
    ks = iter(jax.random.split(key, 32))

    def dense(shape, fan_in, mult=1.0):
        return jax.random.normal(next(ks), shape, jnp.float32) * (mult * fan_in ** -0.5)

    def gain(shape):
        return 1.0 + 0.02 * jax.random.normal(next(ks), shape, jnp.float32)

    L = DEPTH
    x = jax.random.normal(next(ks), (BATCH, SEQ, D_MODEL), jnp.float32)
    mem = jax.random.normal(next(ks), (BATCH, N_MEM, D_MODEL), jnp.float32)
    offset = jax.random.randint(next(ks), (BATCH, 1), 0, 1024, dtype=jnp.int32)
    positions = (jnp.arange(SEQ, dtype=jnp.int32)[None, :] + offset).astype(jnp.int32)
    return {
        "x": x,
        "mem": mem,
        "positions": positions,
        "ffn1_norm": gain((L, D_MODEL)),
        "ffn1_w_gate": dense((L, D_MODEL, D_FF), D_MODEL),
        "ffn1_w_up": dense((L, D_MODEL, D_FF), D_MODEL),
        "ffn1_w_down": dense((L, D_FF, D_MODEL), D_FF),
        "mix_norm": gain((L, D_MODEL)),
        "w_in": dense((L, D_MODEL, IN_PROJ_DIM), D_MODEL),
        "q_norm": gain((L, Q_LORA_RANK)),
        "w_q_up": dense((L, Q_LORA_RANK, MLA_HEADS * (QK_NOPE_DIM + QK_ROPE_DIM)), Q_LORA_RANK),
        "kv_norm": gain((L, KV_LORA_RANK)),
        "w_kv_up": dense((L, KV_LORA_RANK, MLA_HEADS * (QK_NOPE_DIM + V_HEAD_DIM)), KV_LORA_RANK),
        "pool_w": dense((L, POOL_GROUPS, POOL_CH, POOL_CH), POOL_CH),
        "pool_scale": 0.5 + 0.05 * jax.random.normal(next(ks), (L, POOL_WIDTH), jnp.float32),
        "w_out": dense((L, MLA_WIDTH + POOL_WIDTH, D_MODEL), MLA_WIDTH + POOL_WIDTH),
        "xattn_norm": gain((L, D_MODEL)),
        "mem_norm": gain((L, D_MODEL)),
        "w_mq": dense((L, D_MODEL, D_MODEL), D_MODEL),
        "w_mkv": dense((L, D_MODEL, 2 * D_MODEL), D_MODEL),
        "w_mo": dense((L, D_MODEL, D_MODEL), D_MODEL),
        "ffn2_norm": gain((L, D_MODEL)),
        "ffn2_w_gate": dense((L, D_MODEL, D_FF), D_MODEL),
        "ffn2_w_up": dense((L, D_MODEL, D_FF), D_MODEL),
        "ffn2_w_down": dense((L, D_FF, D_MODEL), D_FF),
        "final_norm": gain((D_MODEL,)),
    }


def reference(x, mem, positions, ffn1_norm, ffn1_w_gate, ffn1_w_up, ffn1_w_down, mix_norm, w_in,
              q_norm, w_q_up, kv_norm, w_kv_up, pool_w, pool_scale, w_out, xattn_norm, mem_norm,
              w_mq, w_mkv, w_mo, ffn2_norm, ffn2_w_gate, ffn2_w_up, ffn2_w_down, final_norm):
    h = x
    split_pts = [Q_LORA_RANK, Q_LORA_RANK + KV_LORA_RANK, Q_LORA_RANK + KV_LORA_RANK + QK_ROPE_DIM]
    for l in range(DEPTH):
        h = h + 0.5 * swiglu(rmsnorm(h, ffn1_norm[l]), ffn1_w_gate[l], ffn1_w_up[l], ffn1_w_down[l])
        z = rmsnorm(h, mix_norm[l]) @ w_in[l]
        c_q, c_kv, k_rope, z_pool = jnp.split(z, split_pts, axis=-1)
        a = mla_group(c_q, c_kv, k_rope, positions, q_norm[l], w_q_up[l], kv_norm[l], w_kv_up[l])
        p = pool_group(z_pool, pool_w[l], pool_scale[l])
        h = h + jnp.concatenate([a, p], axis=-1) @ w_out[l]
        h = h + memory_cross_attention(rmsnorm(h, xattn_norm[l]), rmsnorm(mem, mem_norm[l]),
                                       w_mq[l], w_mkv[l], w_mo[l])
        h = h + 0.5 * swiglu(rmsnorm(h, ffn2_norm[l]), ffn2_w_gate[l], ffn2_w_up[l], ffn2_w_down[l])
    return rmsnorm(h, final_norm)
```

```cpp
#include <hip/hip_runtime.h>
#include <cstdio>
#include <cstdint>

#define LAS __attribute__((address_space(3)))
#define GAS __attribute__((address_space(1)))
typedef unsigned short bf16_t;
typedef short bf16x8 __attribute__((ext_vector_type(8)));
typedef short s16x4 __attribute__((ext_vector_type(4)));
typedef float f32x2 __attribute__((ext_vector_type(2)));
typedef float f32x4 __attribute__((ext_vector_type(4)));
typedef float f32x16 __attribute__((ext_vector_type(16)));
typedef unsigned u32x2 __attribute__((ext_vector_type(2)));
typedef unsigned u32x4 __attribute__((ext_vector_type(4)));

constexpr int DM = 1024, NB = 4, SEQ = 4096, M = NB * SEQ;
constexpr int DFF = 2816, NMEM = 256;
constexpr float RMS_EPS = 1e-6f;
constexpr float LOG2E = 1.4426950408889634f;

__device__ __forceinline__ unsigned cvt_pk_bf16(float lo, float hi) { unsigned r; asm volatile("v_cvt_pk_bf16_f32 %0, %1, %2" : "=v"(r) : "v"(lo), "v"(hi)); return r; }
__device__ __forceinline__ float bf2f(unsigned short h) { return __uint_as_float((unsigned)h << 16); }

namespace pg8 {
constexpr int BM = 256, BK = 64, HALF = 128, HTB = HALF * BK * 2, STAGE_BYTES = 8 * HTB, NXCD = 8, WGM = 8;
__host__ __device__ __forceinline__ int lds_byte(int r, int c) { const int st = (r >> 4) * 2 + (c >> 5), rr = r & 15, cc = c & 31, ob = rr * 64 + cc * 2; return st * 1024 + (ob ^ (((ob >> 9) & 1) << 5)); }
__host__ __device__ __forceinline__ void stage_rc(int b, int& R, int& C) { const int st = b / 1024, sb = b % 1024, swz = sb ^ (((sb >> 9) & 1) << 5); R = (st >> 1) * 16 + swz / 64; C = (st & 1) * 32 + (swz % 64) / 2; }
__host__ __device__ __forceinline__ int perm32(int rho) { const int n = rho >> 4, i = rho & 15; return 8 * (i >> 2) + 4 * n + (i & 3); }

struct Unit { int pm, pn; const char* a; const char* b; char* o; };
struct Gemm { int lda, ldb, K; };

__device__ __forceinline__ bool tile_of(int L, int nM, int nN, int& pm, int& pn) {
    const int nwg = nM * nN; if (L >= nwg) return false;
    int wgid = L; { const int q = nwg / NXCD, r = nwg % NXCD, xcd = wgid % NXCD, off = wgid / NXCD; wgid = (xcd < r ? xcd * (q + 1) : r * (q + 1) + (xcd - r) * q) + off; }
    const int nig = WGM * nN, gid = wgid / nig, fm = gid * WGM, gsz = (nM - fm) < WGM ? (nM - fm) : WGM;
    pm = fm + ((wgid % nig) % gsz); pn = (wgid % nig) / gsz; return true;
}

template <class Epi, class Sched, bool ALIGN_EPI>
__device__ __forceinline__ void gemm_phase(LAS unsigned char* lds, const Gemm g, const Sched& S, const Epi& E) {
    int tid_ = threadIdx.x; asm volatile("" : "+v"(tid_));
    const int tid = tid_, wid = __builtin_amdgcn_readfirstlane(tid >> 6), lane = tid & 63, wr = wid >> 2, wc = wid & 3, fr = lane & 15, fq = lane >> 4;
    const int nt = g.K / BK;
    unsigned voffA[2], voffB[2];
#pragma unroll
    for (int i = 0; i < 2; ++i) { int R, C; stage_rc(tid * 16 + i * 8192, R, C); const int Rb = Epi::PERM ? ((R & ~31) + perm32(R & 31)) : R;
        voffA[i] = (unsigned)(R * g.lda + C) * 2u; voffB[i] = (unsigned)(Rb * g.ldb + C) * 2u; }
    const size_t kstep = (size_t)(BK * 2);
    const size_t hstepA = (size_t)HALF * g.lda * 2, hstepB = (size_t)HALF * g.ldb * 2;
    const unsigned ldsw = (unsigned)wid * 1024u;
    const int aoff = lds_byte(wr * 64 + fr, fq * 8), boff = lds_byte(wc * 32 + fr, fq * 8);
#define PG8_SA(b, h) (((b) * 2 + (h)) * HTB)
#define PG8_SB(b, h) ((4 + (b) * 2 + (h)) * HTB)
#define PG8_STAGE(bufoff, gbase, voff) do { _Pragma("unroll") for (int _i = 0; _i < 2; ++_i) \
        __builtin_amdgcn_global_load_lds((const unsigned*)((const char*)(gbase) + (voff)[_i]), (LAS unsigned*)(lds + (bufoff) + ldsw + _i * 8192), 16, 0, 0); } while (0)
#define PG8_LDA(dst, b, h) do { _Pragma("unroll") for (int m = 0; m < 4; ++m) _Pragma("unroll") for (int k = 0; k < 2; ++k) dst[m][k] = *(const LAS bf16x8*)(lds + PG8_SA(b, h) + aoff + m * 2048 + k * 1024); } while (0)
#define PG8_LDB(dst, b, h) do { _Pragma("unroll") for (int n = 0; n < 2; ++n) _Pragma("unroll") for (int k = 0; k < 2; ++k) dst[n][k] = *(const LAS bf16x8*)(lds + PG8_SB(b, h) + boff + n * 2048 + k * 1024); } while (0)
#define PG8_MMA(ai, bj, At, Bt) do { __builtin_amdgcn_s_setprio(1); _Pragma("unroll") for (int m = 0; m < 4; ++m) _Pragma("unroll") for (int n = 0; n < 2; ++n) _Pragma("unroll") for (int k = 0; k < 2; ++k) \
        acc[ai][bj][m][n] = __builtin_amdgcn_mfma_f32_16x16x32_bf16(Bt[n][k], At[m][k], acc[ai][bj][m][n], 0, 0, 0); __builtin_amdgcn_s_setprio(0); } while (0)
#define PG8_WAIT_V(n) asm volatile("s_waitcnt vmcnt(" #n ")" ::: "memory")
#define PG8_WAIT_L(n) asm volatile("s_waitcnt lgkmcnt(" #n ")" ::: "memory")
#define PG8_BAR __builtin_amdgcn_s_barrier()
#define PG8_SCHED __builtin_amdgcn_sched_barrier(0)
    Unit cur, nxt; int ui = 0;
    if (!S.next(0, cur)) return;
    f32x4 acc[2][2][4][2];
#pragma unroll
    for (int a = 0; a < 2; ++a)
#pragma unroll
        for (int b = 0; b < 2; ++b)
#pragma unroll
            for (int m = 0; m < 4; ++m)
#pragma unroll
                for (int n = 0; n < 2; ++n) acc[a][b][m][n] = (f32x4){0.f, 0.f, 0.f, 0.f};
    bf16x8 At[4][2], B0[2][2], B1[2][2];
    const char* cA = cur.a; const char* cB = cur.b;
    PG8_STAGE(PG8_SB(0, 0), cB, voffB); PG8_STAGE(PG8_SB(0, 1), cB + hstepB, voffB); PG8_STAGE(PG8_SA(0, 0), cA, voffA); PG8_STAGE(PG8_SA(0, 1), cA + hstepA, voffA);
    if (wr == 1) PG8_BAR;
    PG8_WAIT_V(2); PG8_BAR;
    PG8_STAGE(PG8_SB(1, 0), cB + kstep, voffB); PG8_STAGE(PG8_SA(1, 0), cA + kstep, voffA); PG8_STAGE(PG8_SB(1, 1), cB + hstepB + kstep, voffB);
    PG8_WAIT_V(6); PG8_BAR;
    for (;;) {
        const bool has_next = S.next(ui + 1, nxt);
        const char* nA = has_next ? nxt.a : cA; const char* nB = has_next ? nxt.b : cB;
        for (int t = 0; t < nt; t += 2) {
            const bool last = (t == nt - 2);
            const char* a1 = cA + (size_t)(t + 1) * kstep;
            const char* a2 = last ? nA : cA + (size_t)(t + 2) * kstep; const char* b2 = last ? nB : cB + (size_t)(t + 2) * kstep;
            const char* a3 = a2 + kstep; const char* b3 = b2 + kstep;
            PG8_LDB(B0, 0, 0); PG8_LDB(B1, 0, 1); PG8_SCHED; PG8_LDA(At, 0, 0); PG8_STAGE(PG8_SA(1, 1), a1 + hstepA, voffA);
            PG8_WAIT_V(8); PG8_WAIT_L(0); PG8_BAR; PG8_MMA(0, 0, At, B0); PG8_MMA(0, 1, At, B1); PG8_BAR; PG8_SCHED;
            PG8_LDA(At, 0, 1); PG8_STAGE(PG8_SB(0, 0), b2, voffB); PG8_STAGE(PG8_SB(0, 1), b2 + hstepB, voffB); PG8_STAGE(PG8_SA(0, 0), a2, voffA);
            PG8_WAIT_V(8); PG8_WAIT_L(0); PG8_BAR; PG8_MMA(1, 0, At, B0); PG8_MMA(1, 1, At, B1); PG8_BAR; PG8_SCHED;
            PG8_LDB(B0, 1, 0); PG8_LDB(B1, 1, 1); PG8_SCHED; PG8_LDA(At, 1, 0); PG8_STAGE(PG8_SA(0, 1), a2 + hstepA, voffA);
            PG8_WAIT_V(8); PG8_WAIT_L(0); PG8_BAR; PG8_MMA(0, 0, At, B0); PG8_MMA(0, 1, At, B1); PG8_BAR; PG8_SCHED;
            PG8_LDA(At, 1, 1); PG8_STAGE(PG8_SB(1, 0), b3, voffB); PG8_STAGE(PG8_SB(1, 1), b3 + hstepB, voffB); PG8_STAGE(PG8_SA(1, 0), a3, voffA);
            PG8_WAIT_V(8); PG8_WAIT_L(0); PG8_BAR; PG8_MMA(1, 0, At, B0); PG8_MMA(1, 1, At, B1); PG8_BAR; PG8_SCHED;
        }
        if constexpr (ALIGN_EPI) { if (wr == 0) PG8_BAR; }
        if constexpr (!Epi::AFTER_DRAIN) { E(acc, cur, wr, wc, fr, fq); }
        if (!has_next) break;
#pragma unroll
        for (int a = 0; a < 2; ++a)
#pragma unroll
            for (int b = 0; b < 2; ++b)
#pragma unroll
                for (int m = 0; m < 4; ++m)
#pragma unroll
                    for (int n = 0; n < 2; ++n) acc[a][b][m][n] = (f32x4){0.f, 0.f, 0.f, 0.f};
        cur = nxt; cA = nA; cB = nB; ++ui;
        if constexpr (ALIGN_EPI) { if (wr == 1) PG8_BAR; }
    }
    PG8_WAIT_V(0);
    if constexpr (!ALIGN_EPI) { if (wr == 0) PG8_BAR; }
    PG8_BAR;
    if constexpr (Epi::AFTER_DRAIN) { E.fused(acc, cur, wr, wc, fr, fq, lds, wid, lane); }
#undef PG8_SA
#undef PG8_SB
#undef PG8_STAGE
#undef PG8_LDA
#undef PG8_LDB
#undef PG8_MMA
#undef PG8_WAIT_V
#undef PG8_WAIT_L
#undef PG8_BAR
#undef PG8_SCHED
}

typedef f32x4 Acc[2][2][4][2];

__device__ __forceinline__ float rstd_of(const float* st, int m, float inv) {
    const float s = (st[m] + st[M + m]) + (st[2 * M + m] + st[3 * M + m]);
    return __builtin_amdgcn_rsqf(s * inv + RMS_EPS);
}
__device__ __forceinline__ u32x4 pack8v(f32x4 a, f32x4 b) { u32x4 w; w.x = cvt_pk_bf16(a[0], a[1]); w.y = cvt_pk_bf16(a[2], a[3]); w.z = cvt_pk_bf16(b[0], b[1]); w.w = cvt_pk_bf16(b[2], b[3]); return w; }

struct EpiStore {
    static constexpr bool PERM = true, AFTER_DRAIN = false;
    const float* st; float inv; int ldo; int stM;
    __device__ __forceinline__ void operator()(const Acc& acc, const Unit& u, int wr, int wc, int fr, int fq) const {
        asm volatile("" : "+v"(fr), "+v"(fq));
        bf16_t* base = (bf16_t*)u.o;
#pragma unroll
        for (int ai = 0; ai < 2; ++ai)
#pragma unroll
            for (int m = 0; m < 4; ++m) {
                const int r = ai * HALF + wr * 64 + m * 16 + fr;
                float sc = 1.f;
                if (st) { const int gm = u.pm * BM + r; const float s = (st[gm] + st[stM + gm]) + (st[2 * stM + gm] + st[3 * stM + gm]); sc = __builtin_amdgcn_rsqf(s * inv + RMS_EPS); }
                bf16_t* rowp = base + (size_t)r * ldo + wc * 32 + 8 * fq;
#pragma unroll
                for (int bj = 0; bj < 2; ++bj) *(u32x4*)(rowp + bj * HALF) = pack8v(acc[ai][bj][m][0] * sc, acc[ai][bj][m][1] * sc);
            }
    }
};

struct EpiSwiGLU {
    static constexpr bool PERM = true, AFTER_DRAIN = false;
    const float* st; bf16_t* act;
    __device__ __forceinline__ void operator()(const Acc& acc, const Unit& u, int wr, int wc, int fr, int fq) const {
        asm volatile("" : "+v"(fr), "+v"(fq));
#pragma unroll
        for (int ai = 0; ai < 2; ++ai)
#pragma unroll
            for (int m = 0; m < 4; ++m) {
                const int gm = u.pm * BM + ai * HALF + wr * 64 + m * 16 + fr;
                const float sc = rstd_of(st, gm, 1.0f / DM);
                f32x4 o[2];
#pragma unroll
                for (int n = 0; n < 2; ++n) { const f32x4 gv = acc[ai][0][m][n] * sc, uv = acc[ai][1][m][n] * sc;
#pragma unroll
                    for (int i = 0; i < 4; ++i) { const float e = __builtin_amdgcn_exp2f(-gv[i] * LOG2E); o[n][i] = gv[i] * uv[i] * __builtin_amdgcn_rcpf(1.0f + e); } }
                *(u32x4*)(act + (size_t)gm * DFF + u.pn * HALF + wc * 32 + 8 * fq) = pack8v(o[0], o[1]);
            }
    }
};

struct EpiZ {
    static constexpr bool PERM = true, AFTER_DRAIN = false;
    const float* st; bf16_t* zb; float* statq; float* statkv;
    __device__ __forceinline__ void operator()(const Acc& acc, const Unit& u, int wr, int wc, int fr, int fq) const {
        asm volatile("" : "+v"(fr), "+v"(fq));
#pragma unroll
        for (int ai = 0; ai < 2; ++ai)
#pragma unroll
            for (int m = 0; m < 4; ++m) {
                const int gm = u.pm * BM + ai * HALF + wr * 64 + m * 16 + fr;
                const float sc = rstd_of(st, gm, 1.0f / DM);
                float q0 = 0.f, q1 = 0.f;
#pragma unroll
                for (int bj = 0; bj < 2; ++bj) { const f32x4 v0 = acc[ai][bj][m][0] * sc, v1 = acc[ai][bj][m][1] * sc;
                    const float q = (v0[0] * v0[0] + v0[1] * v0[1]) + (v0[2] * v0[2] + v0[3] * v0[3]) + (v1[0] * v1[0] + v1[1] * v1[1]) + (v1[2] * v1[2] + v1[3] * v1[3]);
                    if (bj == 0) q0 = q; else q1 = q;
                    *(u32x4*)(zb + (size_t)gm * DM + u.pn * BM + bj * HALF + wc * 32 + 8 * fq) = pack8v(v0, v1); }
                if (u.pn < 2) {
                    float q = (u.pn == 0) ? (q0 + q1) : q0;
                    q += __shfl_xor(q, 16); q += __shfl_xor(q, 32);
                    if (fq == 0) { float* d = (u.pn == 0) ? statq : statkv; d[wc * M + gm] = q; }
                }
            }
    }
};

struct EpiQKV {
    static constexpr bool PERM = true, AFTER_DRAIN = false;
    const float* statq; const float* statkv; const float* cosT; const float* sinT; bf16_t* Q; bf16_t* KN; bf16_t* V; float qscale;
    __device__ __forceinline__ void operator()(const Acc& acc, const Unit& u, int wr, int wc, int fr, int fq) const {
        asm volatile("" : "+v"(fr), "+v"(fq));
        const int c8 = 8 * fq;
        if (u.pn < 2) {
#pragma unroll
            for (int ai = 0; ai < 2; ++ai)
#pragma unroll
                for (int m = 0; m < 4; ++m) {
                    const int gm = u.pm * BM + ai * HALF + wr * 64 + m * 16 + fr; const int b = gm >> 12, s = gm & (SEQ - 1);
                    const float sc = rstd_of(statq, gm, 1.0f / 256.0f) * qscale;
#pragma unroll
                    for (int bj = 0; bj < 2; ++bj) { const int h = 2 * u.pn + bj;
                        *(u32x4*)(Q + ((size_t)(b * 4 + h) * SEQ + s) * 192 + wc * 32 + c8) = pack8v(acc[ai][bj][m][0] * sc, acc[ai][bj][m][1] * sc); }
                }
        } else if (u.pn == 2) {
#pragma unroll
            for (int ai = 0; ai < 2; ++ai)
#pragma unroll
                for (int m = 0; m < 4; ++m) {
                    const int gm = u.pm * BM + ai * HALF + wr * 64 + m * 16 + fr; const int b = gm >> 12, s = gm & (SEQ - 1);
                    const float sc = rstd_of(statq, gm, 1.0f / 256.0f) * qscale;
                    bf16_t* qp = Q + ((size_t)(b * 4 + wc) * SEQ + s) * 192 + 128 + c8;
#pragma unroll
                    for (int n = 0; n < 2; ++n) {
                        const f32x4 cv = *(const f32x4*)(cosT + (size_t)gm * 32 + c8 + 4 * n) * sc, sv = *(const f32x4*)(sinT + (size_t)gm * 32 + c8 + 4 * n) * sc;
                        const f32x4 x1 = acc[ai][0][m][n], x2 = acc[ai][1][m][n];
                        const f32x4 o1 = x1 * cv - x2 * sv, o2 = x1 * sv + x2 * cv;
                        u32x2 w1, w2; w1.x = cvt_pk_bf16(o1[0], o1[1]); w1.y = cvt_pk_bf16(o1[2], o1[3]); w2.x = cvt_pk_bf16(o2[0], o2[1]); w2.y = cvt_pk_bf16(o2[2], o2[3]);
                        *(u32x2*)(qp + 4 * n) = w1; *(u32x2*)(qp + 32 + 4 * n) = w2;
                    }
                    asm volatile("" ::: "memory");
                }
        } else {
            const int h = u.pn - 3;
#pragma unroll
            for (int ai = 0; ai < 2; ++ai)
#pragma unroll
                for (int m = 0; m < 4; ++m) {
                    const int gm = u.pm * BM + ai * HALF + wr * 64 + m * 16 + fr; const int b = gm >> 12, s = gm & (SEQ - 1);
                    const float sc = rstd_of(statkv, gm, 1.0f / 128.0f);
                    const size_t off = ((size_t)(b * 4 + h) * SEQ + s) * 128 + wc * 32 + c8;
                    *(u32x4*)(KN + off) = pack8v(acc[ai][0][m][0] * sc, acc[ai][0][m][1] * sc);
                    *(u32x4*)(V + off) = pack8v(acc[ai][1][m][0] * sc, acc[ai][1][m][1] * sc);
                }
        }
    }
};

struct EpiResid {
    static constexpr bool PERM = false, AFTER_DRAIN = true;
    const float* hin; float* hout; bf16_t* hb; float* stat; float alpha;
    __device__ __forceinline__ void fused(Acc& acc, const Unit& u, int wr, int wc, int fr, int fq, LAS unsigned char* lds, int wid, int lane) const {
        asm volatile("" : "+v"(fr), "+v"(fq));
        LAS float* P = (LAS float*)lds;
        const int col0 = u.pn * BM + wc * 32 + 4 * fq;
#pragma unroll
        for (int ai = 0; ai < 2; ++ai)
#pragma unroll
            for (int m = 0; m < 4; ++m) {
                const int r = ai * HALF + wr * 64 + m * 16 + fr; const size_t off = (size_t)(u.pm * BM + r) * DM + col0;
                float q = 0.f;
#pragma unroll
                for (int bj = 0; bj < 2; ++bj)
#pragma unroll
                    for (int n = 0; n < 2; ++n) { const f32x4 bs = *(const f32x4*)(hin + off + bj * HALF + n * 16); const f32x4 o = bs + acc[ai][bj][m][n] * alpha;
                        *(f32x4*)(hout + off + bj * HALF + n * 16) = o;
                        if (hb) { u32x2 w; w.x = cvt_pk_bf16(o[0], o[1]); w.y = cvt_pk_bf16(o[2], o[3]); *(u32x2*)(hb + off + bj * HALF + n * 16) = w; }
                        q += (o[0] * o[0] + o[1] * o[1]) + (o[2] * o[2] + o[3] * o[3]); }
                q += __shfl_xor(q, 16); q += __shfl_xor(q, 32);
                if (fq == 0) P[r * 4 + wc] = q;
            }
        asm volatile("s_waitcnt lgkmcnt(0)" ::: "memory"); __builtin_amdgcn_s_barrier(); asm volatile("" ::: "memory");
        const int t = wid * 64 + lane;
        if (t < 256) { const float s = (P[t * 4 + 0] + P[t * 4 + 1]) + (P[t * 4 + 2] + P[t * 4 + 3]); stat[u.pn * M + u.pm * BM + t] = s; }
        asm volatile("s_waitcnt lgkmcnt(0)" ::: "memory"); __builtin_amdgcn_s_barrier(); asm volatile("" ::: "memory");
    }
};

struct EpiSoftmax {
    static constexpr bool PERM = true, AFTER_DRAIN = true;
    const float* st; bf16_t* Pout; float scale;
    __device__ __forceinline__ void fused(Acc& acc, const Unit& u, int wr, int wc, int fr, int fq, LAS unsigned char* lds, int wid, int lane) const {
        asm volatile("" : "+v"(fr), "+v"(fq));
        LAS f32x2* X = (LAS f32x2*)lds;
#pragma unroll
        for (int ai = 0; ai < 2; ++ai)
#pragma unroll
            for (int m = 0; m < 4; ++m) {
                const int r = ai * HALF + wr * 64 + m * 16 + fr;
                const float sc = rstd_of(st, u.pm * BM + r, 1.0f / DM) * scale;
                float mx = -3.0e38f;
#pragma unroll
                for (int bj = 0; bj < 2; ++bj)
#pragma unroll
                    for (int n = 0; n < 2; ++n) { acc[ai][bj][m][n] = acc[ai][bj][m][n] * sc; const f32x4 v = acc[ai][bj][m][n]; mx = fmaxf(mx, fmaxf(fmaxf(v[0], v[1]), fmaxf(v[2], v[3]))); }
                mx = fmaxf(mx, __shfl_xor(mx, 16)); mx = fmaxf(mx, __shfl_xor(mx, 32));
                float sum = 0.f;
#pragma unroll
                for (int bj = 0; bj < 2; ++bj)
#pragma unroll
                    for (int n = 0; n < 2; ++n) { f32x4 v = acc[ai][bj][m][n];
#pragma unroll
                        for (int i = 0; i < 4; ++i) { v[i] = __builtin_amdgcn_exp2f(v[i] - mx); sum += v[i]; }
                        acc[ai][bj][m][n] = v; }
                sum += __shfl_xor(sum, 16); sum += __shfl_xor(sum, 32);
                if (fq == 0) X[r * 4 + wc] = (f32x2){mx, sum};
            }
        asm volatile("s_waitcnt lgkmcnt(0)" ::: "memory"); __builtin_amdgcn_s_barrier(); asm volatile("" ::: "memory");
#pragma unroll
        for (int ai = 0; ai < 2; ++ai)
#pragma unroll
            for (int m = 0; m < 4; ++m) {
                const int r = ai * HALF + wr * 64 + m * 16 + fr;
                const f32x2 a = X[r * 4 + 0], b = X[r * 4 + 1], c = X[r * 4 + 2], d = X[r * 4 + 3];
                const float mt = fmaxf(fmaxf(a.x, b.x), fmaxf(c.x, d.x));
                const float l = (a.y * __builtin_amdgcn_exp2f(a.x - mt) + b.y * __builtin_amdgcn_exp2f(b.x - mt)) + (c.y * __builtin_amdgcn_exp2f(c.x - mt) + d.y * __builtin_amdgcn_exp2f(d.x - mt));
                const f32x2 mine = X[r * 4 + wc];
                const float f = __builtin_amdgcn_exp2f(mine.x - mt) * __builtin_amdgcn_rcpf(l);
                bf16_t* rowp = Pout + (size_t)(u.pm * BM + r) * DM + u.pn * BM + wc * 32 + 8 * fq;
#pragma unroll
                for (int bj = 0; bj < 2; ++bj) *(u32x4*)(rowp + bj * HALF) = pack8v(acc[ai][bj][m][0] * f, acc[ai][bj][m][1] * f);
            }
        asm volatile("s_waitcnt lgkmcnt(0)" ::: "memory"); __builtin_amdgcn_s_barrier(); asm volatile("" ::: "memory");
    }
};
}
namespace attn {
constexpr int NW = 8, QBLK = 32, KVBLK = 64, QB = NW * QBLK;
constexpr int SHM_V = KVBLK * 128 * 2, SHM_KN = KVBLK * 128 * 2;
constexpr int OFF_V = 0, OFF_KN = 2 * SHM_V, OFF_KP = OFF_KN + 2 * SHM_KN, OFF_WS = OFF_KP + 16384, LDS_BYTES = OFF_WS + NW * 64 * 4;
constexpr float THR = 8.f;

#define KSWZ(row, colB) ((row) * 256 + ((colB) ^ (((row) & 7) << 4)))
#define SBAR() __builtin_amdgcn_sched_barrier(0)
__device__ __forceinline__ int v_st(int k, int c) { const int kk = (k & ~0xC) | ((k & 4) << 1) | ((k & 8) >> 1); return ((kk >> 3) * 4 + (c >> 5)) * 512 + ((kk & 7) * 32 + (c & 31)) * 2; }
__device__ __forceinline__ int v_rd_base(int lane) { return ((lane & 3) << 3) | (((lane >> 2) & 3) << 6) | (((lane >> 4) & 1) << 5) | (((lane >> 5) & 1) << 8); }
constexpr int v_rd_off(int d0, int ks, int half) { return d0 * 512 + ks * 4096 + half * 2048; }
__device__ __forceinline__ int crow(int r, int hi) { return (r & 3) + 8 * (r >> 2) + 4 * hi; }
__device__ __forceinline__ unsigned cvtpk(float lo, float hi) { unsigned r; asm volatile("v_cvt_pk_bf16_f32 %0, %1, %2" : "=v"(r) : "v"(lo), "v"(hi)); return r; }
__device__ __forceinline__ bf16x8 load8(const bf16_t* p) { return *reinterpret_cast<const bf16x8*>(p); }

__device__ __forceinline__ void mask_tile(f32x16& p0, f32x16& p1, int dq) {
    const float NEG = -__builtin_inff();
#pragma unroll
    for (int r = 0; r < 16; ++r) {
        const int c = (r & 3) + 8 * (r >> 2);
        if (dq - c < 0) p0[r] = NEG;
        if (dq - c - 32 < 0) p1[r] = NEG;
    }
}
__device__ __forceinline__ void partialSM(f32x16& p0, f32x16& p1, float& m_reg, float& mn, float& alpha) {
    float pmax = p0[0]; for (int r = 1; r < 16; ++r) pmax = fmaxf(pmax, p0[r]); for (int r = 0; r < 16; ++r) pmax = fmaxf(pmax, p1[r]);
    { auto rr = __builtin_amdgcn_permlane32_swap(__float_as_uint(pmax), __float_as_uint(pmax), false, false);
      pmax = fmaxf(__uint_as_float(rr[0]), __uint_as_float(rr[1])); }
    if (__builtin_expect(__all((pmax - m_reg) <= THR), 1)) { mn = m_reg; alpha = 1.f; }
    else { mn = fmaxf(m_reg, pmax); alpha = __builtin_amdgcn_exp2f(m_reg - mn); m_reg = mn; }
    for (int r = 0; r < 16; ++r) p0[r] = p0[r] - mn; for (int r = 0; r < 16; ++r) p1[r] = p1[r] - mn;
    for (int r = 0; r < 16; ++r) p0[r] = __builtin_amdgcn_exp2f(p0[r]);
}
__device__ __forceinline__ void finishSM(f32x16& p0, f32x16& p1, float alpha, float& l_reg, bf16x8& pa0, bf16x8& pa1, bf16x8& pa2, bf16x8& pa3) {
    for (int r = 0; r < 16; ++r) p1[r] = __builtin_amdgcn_exp2f(p1[r]);
    float ps = 0; for (int r = 0; r < 16; ++r) ps += p0[r]; for (int r = 0; r < 16; ++r) ps += p1[r];
    { auto rr = __builtin_amdgcn_permlane32_swap(__float_as_uint(ps), __float_as_uint(ps), false, false);
      ps = __uint_as_float(rr[0]) + __uint_as_float(rr[1]); }
    l_reg = l_reg * alpha + ps;
#define PK4(P, B_, OUT) do { unsigned a0 = cvtpk(P[B_+0], P[B_+1]), a1 = cvtpk(P[B_+2], P[B_+3]);                          \
        unsigned b0 = cvtpk(P[B_+4], P[B_+5]), b1 = cvtpk(P[B_+6], P[B_+7]);                                             \
        auto r0 = __builtin_amdgcn_permlane32_swap(a0, b0, false, false); auto r1 = __builtin_amdgcn_permlane32_swap(a1, b1, false, false); \
        u32x4 w = {r0[0], r1[0], r0[1], r1[1]}; OUT = *reinterpret_cast<bf16x8*>(&w); } while (0)
    PK4(p0, 0, pa0); PK4(p0, 8, pa1); PK4(p1, 0, pa2); PK4(p1, 8, pa3);
#undef PK4
}
template <int KB>
__device__ __forceinline__ void qkt(f32x16& p0, f32x16& p1, const char* lds, int r32, int hi, const bf16x8* qr) {
    p0 = f32x16{}; p1 = f32x16{};
    const char* kb[4];
#pragma unroll
    for (int dd = 0; dd < 4; ++dd) kb[dd] = lds + OFF_KN + KB * SHM_KN + KSWZ(r32, (dd * 16 + hi * 8) * 2);
#pragma unroll
    for (int d0 = 0; d0 < 8; ++d0) { const char* a = kb[d0 & 3] + (d0 >> 2) * 128;
        bf16x8 b0 = *reinterpret_cast<const bf16x8*>(a);
        bf16x8 b1 = *reinterpret_cast<const bf16x8*>(a + 32 * 256);
        p0 = __builtin_amdgcn_mfma_f32_32x32x16_bf16(b0, qr[d0], p0, 0, 0, 0);
        p1 = __builtin_amdgcn_mfma_f32_32x32x16_bf16(b1, qr[d0], p1, 0, 0, 0); }
#pragma unroll
    for (int d0 = 0; d0 < 4; ++d0) { const char* a = kb[d0] + (OFF_KP - OFF_KN - KB * SHM_KN + KB * 128);
        bf16x8 b0 = *reinterpret_cast<const bf16x8*>(a);
        bf16x8 b1 = *reinterpret_cast<const bf16x8*>(a + 32 * 256);
        p0 = __builtin_amdgcn_mfma_f32_32x32x16_bf16(b0, qr[8 + d0], p0, 0, 0, 0);
        p1 = __builtin_amdgcn_mfma_f32_32x32x16_bf16(b1, qr[8 + d0], p1, 0, 0, 0); }
}
template <int VB>
__device__ __forceinline__ void pv_tile(f32x16* o, int vb0, bf16x8 pa0, bf16x8 pa1, bf16x8 pa2, bf16x8 pa3) {
#define TRRD(dst, off) asm volatile("ds_read_b64_tr_b16 %0, %1 offset:%2" : "=&v"(dst) : "v"(vb0), "i"(off) : "memory")
#define PV_D0(d0) do { s16x4 l0, l1, l2, l3, h0, h1, h2, h3; constexpr int b_ = VB * SHM_V + v_rd_off(d0, 0, 0); \
        TRRD(l0, b_); TRRD(h0, b_ + 2048); TRRD(l1, b_ + 4096); TRRD(h1, b_ + 6144); TRRD(l2, b_ + 8192); TRRD(h2, b_ + 10240); TRRD(l3, b_ + 12288); TRRD(h3, b_ + 14336); \
        asm volatile("s_waitcnt lgkmcnt(0)" ::: "memory"); SBAR();   \
        o[d0] = __builtin_amdgcn_mfma_f32_32x32x16_bf16(pa0, (bf16x8){l0[0], l0[1], l0[2], l0[3], h0[0], h0[1], h0[2], h0[3]}, o[d0], 0, 0, 0);   \
        o[d0] = __builtin_amdgcn_mfma_f32_32x32x16_bf16(pa1, (bf16x8){l1[0], l1[1], l1[2], l1[3], h1[0], h1[1], h1[2], h1[3]}, o[d0], 0, 0, 0);   \
        o[d0] = __builtin_amdgcn_mfma_f32_32x32x16_bf16(pa2, (bf16x8){l2[0], l2[1], l2[2], l2[3], h2[0], h2[1], h2[2], h2[3]}, o[d0], 0, 0, 0);   \
        o[d0] = __builtin_amdgcn_mfma_f32_32x32x16_bf16(pa3, (bf16x8){l3[0], l3[1], l3[2], l3[3], h3[0], h3[1], h3[2], h3[3]}, o[d0], 0, 0, 0); } while (0)
    PV_D0(0); PV_D0(1); PV_D0(2); PV_D0(3);
#undef PV_D0
#undef TRRD
}

struct Blk { const bf16_t* Q; const bf16_t* KN; const bf16_t* KP; const bf16_t* V; bf16_t* O; int P0, j_lo, j_hi; float* part; unsigned* flag; unsigned* tmo; };
template <int MODE>
__device__ __forceinline__ void block(const Blk& cur, char* lds) {
    int tid_ = threadIdx.x; asm volatile("" : "+v"(tid_));
    const int tid = tid_, wid = __builtin_amdgcn_readfirstlane(tid >> 6), lane = tid & 63, r32 = lane & 31, hi = lane >> 5;
    const int j_lo = cur.j_lo, NT = cur.j_hi - cur.j_lo;
    const int qlo = cur.P0 + wid * QBLK, qm = qlo + r32 - 4 * hi;
    char* V_lds = lds + OFF_V; char* KN_lds = lds + OFF_KN; char* KP_lds = lds + OFF_KP;
    float* ws = (float*)(lds + OFF_WS) + wid * 64; float* li_l = ws, * al_l = ws + 32;
    float m_reg = -1e30f, l_reg = 0; f32x16 o[4] = {};
    const int sr = tid >> 4, sc = (tid & 15) * 8, vst0 = v_st(sr, sc), vst1 = v_st(32 + sr, sc), kws = KSWZ(sr, sc * 2);
    const int pr = tid >> 3, pc = (tid & 7) * 8, kpw = KSWZ(pr, pc * 2);
    const int vb0 = (int)(uintptr_t)V_lds + v_rd_base(lane);
    const bf16_t* Kh = cur.KN; const bf16_t* Kp = cur.KP; const bf16_t* Vh = cur.V;
    bf16x8 st_v0, st_v1, st_k0, st_k1, st_k2;
    bf16x8 qr[12];
#define RESC(a) do { if (__any((a) < 1.f)) { if (hi == 0) al_l[r32] = (a); asm volatile("s_waitcnt lgkmcnt(0)" ::: "memory");              \
                     for (int d_ = 0; d_ < 4; ++d_) for (int r = 0; r < 16; ++r) o[d_][r] *= al_l[crow(r, hi)]; } } while (0)
#define KBASE(t) ((j_lo + (t)) * KVBLK)
#define MASKT(P0_, P1_, t) do { const int kb_ = KBASE(t); if (kb_ + KVBLK - 1 > qlo) mask_tile(P0_, P1_, qm - kb_); } while (0)
#define VMW() asm volatile("s_waitcnt vmcnt(0)" ::: "memory")
#define SLOAD(k0) do { st_v0 = load8(Vh + (size_t)((k0) + sr) * 128 + sc); st_v1 = load8(Vh + (size_t)((k0) + 32 + sr) * 128 + sc);              \
                       st_k0 = load8(Kh + (size_t)((k0) + sr) * 128 + sc); st_k1 = load8(Kh + (size_t)((k0) + 32 + sr) * 128 + sc);              \
                       st_k2 = load8(Kp + (size_t)((k0) + pr) * 64 + pc); } while (0)
#define SWRITE_K(bf) do { *(bf16x8*)(KN_lds + (bf) * SHM_KN + kws) = st_k0; *(bf16x8*)(KN_lds + (bf) * SHM_KN + kws + 32 * 256) = st_k1; *(bf16x8*)(KP_lds + (bf) * 128 + kpw) = st_k2; } while (0)
#define SWRITE_V(bf) do { *(bf16x8*)(V_lds + (bf) * SHM_V + vst0) = st_v0; *(bf16x8*)(V_lds + (bf) * SHM_V + vst1) = st_v1; } while (0)
#pragma unroll
    for (int d0 = 0; d0 < 12; ++d0) qr[d0] = load8(cur.Q + (size_t)(wid * QBLK + r32) * 192 + d0 * 16 + hi * 8);
    SLOAD(KBASE(0)); VMW(); SWRITE_K(0); SWRITE_V(0); SBAR();
    __syncthreads();
    f32x16 pA0, pA1, pB0, pB1; float mnA, mnB, alA, alB; bf16x8 pa0, pa1, pa2, pa3;
    if (NT > 1) SLOAD(KBASE(1));
    SBAR(); qkt<0>(pA0, pA1, lds, r32, hi, qr);
    MASKT(pA0, pA1, 0); partialSM(pA0, pA1, m_reg, mnA, alA);
    if (NT > 1) { VMW(); SWRITE_K(1); SWRITE_V(1); }
    __syncthreads();
#define HALF_STEP(PX0, PX1, mnX, alX, PY0, PY1, alY, t, KB, VB, SB) do {                                                      \
        SBAR(); qkt<KB>(PX0, PX1, lds, r32, hi, qr);                                                                          \
        finishSM(PY0, PY1, alY, l_reg, pa0, pa1, pa2, pa3); SBAR();                                                           \
        if ((t) + 1 < NT) { SLOAD(KBASE((t) + 1)); SBAR(); }                                                                  \
        pv_tile<VB>(o, vb0, pa0, pa1, pa2, pa3); MASKT(PX0, PX1, (t)); partialSM(PX0, PX1, m_reg, mnX, alX);                  \
        __syncthreads();                                                                                                      \
        if ((t) + 1 < NT) { VMW(); SWRITE_K(SB); SWRITE_V(SB); }                                                              \
        RESC(alX); __syncthreads(); } while (0)
    for (int t = 1; t + 1 < NT; t += 2) {
        HALF_STEP(pB0, pB1, mnB, alB, pA0, pA1, alA, t, 1, 0, 0);
        HALF_STEP(pA0, pA1, mnA, alA, pB0, pB1, alB, t + 1, 0, 1, 1);
    }
    const bool even = (NT & 1) == 0;
    if (even) { SBAR(); qkt<1>(pB0, pB1, lds, r32, hi, qr); SBAR(); }
    finishSM(pA0, pA1, alA, l_reg, pa0, pa1, pa2, pa3); SBAR();
    pv_tile<0>(o, vb0, pa0, pa1, pa2, pa3);
    if (even) { MASKT(pB0, pB1, NT - 1); partialSM(pB0, pB1, m_reg, mnB, alB); __syncthreads(); RESC(alB);
        finishSM(pB0, pB1, alB, l_reg, pa0, pa1, pa2, pa3); SBAR(); pv_tile<1>(o, vb0, pa0, pa1, pa2, pa3); }
    SBAR();
    if constexpr (MODE == 1) {
        float* pp = cur.part + (size_t)wid * (66 * 64) + lane;
#pragma unroll
        for (int d0 = 0; d0 < 4; ++d0)
#pragma unroll
            for (int r = 0; r < 16; ++r) pp[(d0 * 16 + r) * 64] = o[d0][r];
        pp[64 * 64] = m_reg; pp[65 * 64] = l_reg;
        asm volatile("s_waitcnt vmcnt(0)" ::: "memory");
        __syncthreads();
        if (tid == 0) { __builtin_amdgcn_fence(__ATOMIC_RELEASE, "agent"); asm volatile("s_waitcnt vmcnt(0)" ::: "memory");
            __hip_atomic_store(cur.flag, 1u, __ATOMIC_RELAXED, __HIP_MEMORY_SCOPE_AGENT); }
    } else {
        float f_own, f_oth = 0.f;
        if constexpr (MODE == 2) {
            if (tid == 0) { unsigned sp = 0;
                while (__hip_atomic_load(cur.flag, __ATOMIC_RELAXED, __HIP_MEMORY_SCOPE_AGENT) == 0u) { __builtin_amdgcn_s_sleep(2);
                    if ((++sp & 255u) == 0u) { if (__hip_atomic_load(cur.tmo, __ATOMIC_RELAXED, __HIP_MEMORY_SCOPE_AGENT)) break; if (sp > (1u << 20)) { atomicAdd(cur.tmo, 1u); break; } } }
                __builtin_amdgcn_fence(__ATOMIC_ACQUIRE, "agent"); asm volatile("s_waitcnt vmcnt(0)" ::: "memory"); }
            __syncthreads();
            const float* pp = cur.part + (size_t)wid * (66 * 64) + lane;
            const float m1 = pp[64 * 64], l1 = pp[65 * 64];
            const float mt = fmaxf(m1, m_reg), a1 = __builtin_amdgcn_exp2f(m1 - mt), a2 = __builtin_amdgcn_exp2f(m_reg - mt);
            const float inv = __builtin_amdgcn_rcpf(l1 * a1 + l_reg * a2);
            f_own = a2 * inv; f_oth = a1 * inv;
        } else { f_own = __builtin_amdgcn_rcpf(l_reg); }
        if (hi == 0) { li_l[r32] = f_own; al_l[r32] = f_oth; } asm volatile("s_waitcnt lgkmcnt(0)" ::: "memory");
        bf16_t* Ow = cur.O + (size_t)(wid * QBLK) * DM;
#pragma unroll
        for (int r = 0; r < 16; ++r) { const int orow = crow(r, hi); const float fo = li_l[orow]; float fp = 0.f; if constexpr (MODE == 2) fp = al_l[orow];
#pragma unroll
            for (int d0 = 0; d0 < 4; ++d0) { float v = o[d0][r] * fo;
                if constexpr (MODE == 2) { v += cur.part[(size_t)wid * (66 * 64) + (d0 * 16 + r) * 64 + lane] * fp; }
                const float vn = __shfl_xor(v, 1);
                if ((r32 & 1) == 0) *(unsigned*)(Ow + (size_t)orow * DM + d0 * 32 + r32) = cvtpk(v, vn); } }
    }
    __syncthreads();
#undef RESC
#undef KBASE
#undef MASKT
#undef VMW
#undef SLOAD
#undef SWRITE_K
#undef SWRITE_V
#undef HALF_STEP
}
#undef KSWZ
#undef SBAR
}
constexpr int NWAVES = 8;
#ifndef MK_PER_PHASE
#define MK_PER_PHASE 0
#endif
constexpr int N_PHASES = 12;

constexpr size_t MiB = 1u << 20;
constexpr size_t WS_CTL = 0, CTL_ZERO_BYTES = 1 * MiB;
constexpr size_t WS_W1GU = 1 * MiB;
constexpr size_t WS_W1D  = 12 * MiB;
constexpr size_t WS_W2GU = WS_W1D + 11 * MiB / 2;
constexpr size_t WS_W2D  = WS_W2GU + 11 * MiB;
constexpr size_t WS_WIN  = 34 * MiB;
constexpr size_t WS_WQKV = 36 * MiB;
constexpr size_t WS_WOUT = 37 * MiB;
constexpr size_t WS_WMQN = 39 * MiB;
constexpr size_t WS_WMOT = 41 * MiB;
constexpr size_t WS_WMKV = 43 * MiB;
constexpr size_t WS_WEFF = 47 * MiB;
constexpr size_t WS_WVO  = 55 * MiB;
constexpr size_t WS_HB   = 63 * MiB;
constexpr size_t WS_ACT  = 95 * MiB;
constexpr size_t WS_ZB   = 95 * MiB;
constexpr size_t WS_Q    = 127 * MiB;
constexpr size_t WS_KN   = 151 * MiB;
constexpr size_t WS_V    = 167 * MiB;
constexpr size_t WS_A2   = 183 * MiB;
constexpr size_t WS_KM   = 215 * MiB;
constexpr size_t WS_VM   = 217 * MiB;
constexpr size_t WS_MEMB = 219 * MiB;
constexpr size_t WS_KPE  = 221 * MiB;
constexpr size_t WS_COS  = 223 * MiB;
constexpr size_t WS_SIN  = 225 * MiB;
constexpr size_t WS_STAT = 227 * MiB;
constexpr size_t STAT_BYTES = 4 * (size_t)M * 4;
constexpr size_t WS_PART = 229 * MiB;
constexpr size_t WS_END  = 246 * MiB;
enum { ST_X = 0, ST_H1, ST_H2, ST_H3, ST_H4, ST_Q, ST_KV, ST_MEM };
constexpr int CW_TMO = 0, CW_CODE = 1, CW_BAR = 4096, CW_AFLAG = 16384;

constexpr int RING_BYTES = 131072, LDSCTL_OFF = RING_BYTES, MISC_OFF = LDSCTL_OFF + 320, LDS_BYTES = 147456;

typedef GAS unsigned gu32;
#define RLX_AGENT __ATOMIC_RELAXED, __HIP_MEMORY_SCOPE_AGENT
#define LDS_WAIT() asm volatile("s_waitcnt lgkmcnt(0)" ::: "memory")
#define VM_WAIT() asm volatile("s_waitcnt vmcnt(0)" ::: "memory")
__device__ __forceinline__ unsigned f2bf(float f) { unsigned u = __builtin_bit_cast(unsigned, f); return (u + 0x7fffu + ((u >> 16) & 1u)) >> 16; }
__device__ __forceinline__ unsigned pk2(float lo, float hi) { return f2bf(lo) | (f2bf(hi) << 16); }

#define XB_TMO      128
#define XB_XCNT(j)  (256  + 64 * (j))
#define XB_XSUB(j)  (1280 + 64 * (j))
#define XB_XGEN(j)  (2304 + 64 * (j))
#define XB_TOP      3328
#define XB_TOPGEN   3392
#define XCD_BAR_WORDS 3456
#define XB_SPIN_CAP (1u << 18)
__device__ __forceinline__ unsigned xb_ld(unsigned* p)              { return __hip_atomic_load(p, __ATOMIC_RELAXED, __HIP_MEMORY_SCOPE_AGENT); }
__device__ __forceinline__ unsigned xb_add(unsigned* p, unsigned v) { return __hip_atomic_fetch_add(p, v, __ATOMIC_RELAXED, __HIP_MEMORY_SCOPE_AGENT); }
__device__ __forceinline__ unsigned xb_xcc_id() { return (unsigned)__builtin_amdgcn_s_getreg((3 << 11) | 20) & 0xFu; }
#define XB_SPIN(cond, bar) do { unsigned _sp = 0; while (cond) { __builtin_amdgcn_s_sleep(1); \
    if ((++_sp & 255u) == 0u) { if (xb_ld(&(bar)[XB_TMO])) break; if (_sp > XB_SPIN_CAP) { atomicAdd(&(bar)[XB_TMO], 1u); break; } } } } while (0)
struct XcdBarrier { unsigned* bar; unsigned x; volatile LAS unsigned* st; };
__device__ __forceinline__ XcdBarrier xcd_barrier_post(unsigned* bar, volatile LAS unsigned* st) {
    XcdBarrier b; b.bar = bar; b.x = xb_xcc_id(); b.st = st;
    if (threadIdx.x == 0) (void)xb_add(&bar[XB_XCNT(b.x)], 1u);
    return b;
}
__device__ __forceinline__ void xcd_barrier_complete(unsigned* bar, unsigned x, unsigned& nloc, unsigned& nx) {
    const unsigned G = gridDim.x * gridDim.y * gridDim.z;
    unsigned sum, cnt, mine, sp = 0u;
    for (;;) {
        sum = 0u; cnt = 0u; mine = 0u;
#pragma unroll
        for (unsigned j = 0; j < 16; ++j) { const unsigned c = xb_ld(&bar[XB_XCNT(j)]); sum += c; cnt += (c > 0u) ? 1u : 0u; mine = (j == x) ? c : mine; }
        if (sum == G) break;
        __builtin_amdgcn_s_sleep(1);
        if ((++sp & 255u) == 0u) { if (xb_ld(&bar[XB_TMO])) break; if (sp > XB_SPIN_CAP) { atomicAdd(&bar[XB_TMO], 1u); break; } }
    }
    nloc = mine > 0u ? mine : 1u; nx = cnt > 0u ? cnt : 1u;
}
__device__ __forceinline__ void xcd_barrier(const XcdBarrier& b) {
    asm volatile("s_waitcnt vmcnt(0)" ::: "memory");
    __syncthreads();
    if (threadIdx.x == 0) {
        unsigned* bar = b.bar;
        __builtin_amdgcn_s_waitcnt(0);
        unsigned nloc = b.st[0], nx = b.st[1];
        if (nloc == 0u) { xcd_barrier_complete(bar, b.x, nloc, nx); b.st[0] = nloc; b.st[1] = nx; }
        const unsigned old = xb_add(&bar[XB_XSUB(b.x)], 1u);
        const unsigned gen = old / nloc;
        if (old + 1u == (gen + 1u) * nloc) {
            __builtin_amdgcn_fence(__ATOMIC_RELEASE, "agent");
            asm volatile("s_waitcnt vmcnt(0)" ::: "memory");
            const unsigned og = xb_add(&bar[XB_TOP], 1u);
            const unsigned tg = og / nx;
            if (og + 1u == (tg + 1u) * nx) xb_add(&bar[XB_TOPGEN], 1u);
            else XB_SPIN(xb_ld(&bar[XB_TOPGEN]) == tg, bar);
            __builtin_amdgcn_fence(__ATOMIC_ACQUIRE, "agent");
            xb_add(&bar[XB_XGEN(b.x)], 1u);
            asm volatile("s_waitcnt vmcnt(0)" ::: "memory");
        } else {
            XB_SPIN(xb_ld(&bar[XB_XGEN(b.x)]) == gen, bar);
            __builtin_amdgcn_fence(__ATOMIC_ACQUIRE, "agent");
            asm volatile("s_waitcnt vmcnt(0)" ::: "memory");
        }
    }
    __syncthreads();
}

__device__ __forceinline__ float wave_sum(float v) {
#pragma unroll
    for (int o = 1; o < 64; o <<= 1) v += __shfl_xor(v, o);
    return v;
}
template <class Src, class RowMap>
__device__ __forceinline__ void tr_item(const Src& S, const RowMap& R, bf16_t* dst, int dst_ld, int kcol0, int k0, int n0, LAS float* scr, int lane) {
    S.fill(scr, k0, n0, lane);
    LDS_WAIT(); asm volatile("" ::: "memory");
    const int c = lane & 7;
#pragma unroll
    for (int j = 0; j < 4; ++j) { const int n = (lane >> 3) + 8 * j; const LAS float* s = scr + (8 * c) * 33 + n;
        u32x4 o; o.x = pk2(s[0 * 33], s[1 * 33]); o.y = pk2(s[2 * 33], s[3 * 33]); o.z = pk2(s[4 * 33], s[5 * 33]); o.w = pk2(s[6 * 33], s[7 * 33]);
        *(GAS u32x4*)(dst + (size_t)R(n0 + n) * dst_ld + kcol0 + k0 + 8 * c) = o; }
    LDS_WAIT(); asm volatile("" ::: "memory");
}
struct SrcW {
    const float* W; int ldw; const float* gain;
    __device__ __forceinline__ void fill(LAS float* scr, int k0, int n0, int lane) const {
#pragma unroll 8
        for (int i = 0; i < 32; ++i) { const int kk = 2 * i + (lane >> 5); const float g = gain ? gain[k0 + kk] : 1.f; scr[kk * 33 + (lane & 31)] = W[(size_t)(k0 + kk) * ldw + n0 + (lane & 31)] * g; }
    }
};
struct SrcWpp {
    const float* pw; const float* ps; const float* wo;
    __device__ __forceinline__ void fill(LAS float* scr, int k0, int n0, int lane) const {
        const int g = k0 >> 7, c0 = (k0 & 127) + (lane >> 5), n = n0 + (lane & 31);
        float acc[32];
#pragma unroll
        for (int i = 0; i < 32; ++i) acc[i] = 0.f;
        const float* pwg = pw + (size_t)g * 128 * 128 + (size_t)c0 * 128;
        for (int j = 0; j < 128; ++j) {
            const float wv = ps[g * 128 + j] * wo[(size_t)(512 + g * 128 + j) * DM + n];
#pragma unroll
            for (int i = 0; i < 32; ++i) acc[i] += pwg[(size_t)(2 * i) * 128 + j] * wv;
        }
#pragma unroll
        for (int i = 0; i < 32; ++i) scr[(2 * i + (lane >> 5)) * 33 + (lane & 31)] = acc[i];
    }
};
struct RmOff { int off; __device__ __forceinline__ int operator()(int n) const { return off + n; } };
struct RmGate { int up; __device__ __forceinline__ int operator()(int n) const { return (n >> 7) * 256 + up * 128 + (n & 127); } };
struct RmWin { __device__ __forceinline__ int operator()(int n) const { return n < 448 ? n : n + 64; } };
struct RmQup { __device__ __forceinline__ int operator()(int n) const { const int h = n / 192, t = n - h * 192;
    if (t < 128) return (h >> 1) * 256 + (h & 1) * 128 + t; const int j = t - 128; return 512 + (j >> 5) * 128 + h * 32 + (j & 31); } };

struct Frame {
    LAS unsigned char* lds; volatile LAS unsigned* MISC; gu32* ctl;
    int tid, lane, wave, vcu, G;
    unsigned char* ws;
    const float* in[26]; float* out;
};
__device__ __forceinline__ float* stat_ptr(unsigned char* ws, int which) { return (float*)(ws + WS_STAT + (size_t)which * STAT_BYTES); }

__device__ __forceinline__ void sincos_d(double a, double& s, double& c) {
    const double k = __builtin_rint(a * 0.63661977236758134308);
    const double r = __builtin_fma(-k, 1.2246467991473532e-16 * 0.5, __builtin_fma(-k, 1.5707963267948966, a));
    const int q = ((int)k) & 3;
    const double r2 = r * r;
    double sp = -7.6471637318198164759e-13; sp = sp * r2 + 1.6059043836821614599e-10; sp = sp * r2 - 2.5052108385441718775e-08; sp = sp * r2 + 2.7557319223985890653e-06;
    sp = sp * r2 - 1.9841269841269841270e-04; sp = sp * r2 + 8.3333333333333333333e-03; sp = sp * r2 - 1.6666666666666666667e-01; sp = sp * r2 * r + r;
    double cp = 4.7794773323873852974e-14; cp = cp * r2 - 1.1470745597729724714e-11; cp = cp * r2 + 2.0876756987868098979e-09; cp = cp * r2 - 2.7557319223985890653e-07;
    cp = cp * r2 + 2.4801587301587301587e-05; cp = cp * r2 - 1.3888888888888888889e-03; cp = cp * r2 + 4.1666666666666666667e-02; cp = cp * r2 - 0.5; cp = cp * r2 + 1.0;
    s = (q == 0) ? sp : (q == 1) ? cp : (q == 2) ? -sp : -cp;
    c = (q == 0) ? cp : (q == 1) ? -sp : (q == 2) ? -cp : sp;
}

__device__ __forceinline__ void p0_prologue(Frame& F) {
    LAS float* scr = (LAS float*)(F.lds + F.wave * 16384);
    const int gw = F.vcu * NWAVES + F.wave, NGW = F.G * NWAVES, lane = F.lane;
    unsigned char* ws = F.ws;
    constexpr int I_PP = 8 * 32, I_FU = 16 * 88, I_FD = 44 * 32, I_IN = 16 * 30, I_QU = 4 * 24, I_KU = 2 * 32, I_WO = 8 * 32, I_MO = 16 * 32, I_MKV = 16 * 64;
    constexpr int NITEMS = I_PP + 4 * I_FU + 2 * I_FD + I_IN + I_QU + I_KU + I_WO + I_MO + I_MKV;
    for (int it = gw; it < NITEMS; it += NGW) {
        int r = it;
        if (r < I_PP) { SrcWpp S{F.in[13], F.in[14], F.in[15]}; tr_item(S, RmOff{0}, (bf16_t*)(ws + WS_WOUT), DM, 512, (r / 32) * 64, (r % 32) * 32, scr, lane); continue; } r -= I_PP;
        if (r < I_FU) { SrcW S{F.in[4], DFF, F.in[3]}; tr_item(S, RmGate{0}, (bf16_t*)(ws + WS_W1GU), DM, 0, (r / 88) * 64, (r % 88) * 32, scr, lane); continue; } r -= I_FU;
        if (r < I_FU) { SrcW S{F.in[5], DFF, F.in[3]}; tr_item(S, RmGate{1}, (bf16_t*)(ws + WS_W1GU), DM, 0, (r / 88) * 64, (r % 88) * 32, scr, lane); continue; } r -= I_FU;
        if (r < I_FU) { SrcW S{F.in[22], DFF, F.in[21]}; tr_item(S, RmGate{0}, (bf16_t*)(ws + WS_W2GU), DM, 0, (r / 88) * 64, (r % 88) * 32, scr, lane); continue; } r -= I_FU;
        if (r < I_FU) { SrcW S{F.in[23], DFF, F.in[21]}; tr_item(S, RmGate{1}, (bf16_t*)(ws + WS_W2GU), DM, 0, (r / 88) * 64, (r % 88) * 32, scr, lane); continue; } r -= I_FU;
        if (r < I_FD) { SrcW S{F.in[6], DM, nullptr}; tr_item(S, RmOff{0}, (bf16_t*)(ws + WS_W1D), DFF, 0, (r / 32) * 64, (r % 32) * 32, scr, lane); continue; } r -= I_FD;
        if (r < I_FD) { SrcW S{F.in[24], DM, nullptr}; tr_item(S, RmOff{0}, (bf16_t*)(ws + WS_W2D), DFF, 0, (r / 32) * 64, (r % 32) * 32, scr, lane); continue; } r -= I_FD;
        if (r < I_IN) { SrcW S{F.in[8], 960, F.in[7]}; tr_item(S, RmWin{}, (bf16_t*)(ws + WS_WIN), DM, 0, (r / 30) * 64, (r % 30) * 32, scr, lane); continue; } r -= I_IN;
        if (r < I_QU) { SrcW S{F.in[10], 768, F.in[9]}; tr_item(S, RmQup{}, (bf16_t*)(ws + WS_WQKV), 256, 0, (r / 24) * 64, (r % 24) * 32, scr, lane); continue; } r -= I_QU;
        if (r < I_KU) { SrcW S{F.in[12], 1024, F.in[11]}; tr_item(S, RmOff{768}, (bf16_t*)(ws + WS_WQKV), 256, 0, (r / 32) * 64, (r % 32) * 32, scr, lane); continue; } r -= I_KU;
        if (r < I_WO) { SrcW S{F.in[15], DM, nullptr}; tr_item(S, RmOff{0}, (bf16_t*)(ws + WS_WOUT), DM, 0, (r / 32) * 64, (r % 32) * 32, scr, lane); continue; } r -= I_WO;
        if (r < I_MO) { SrcW S{F.in[20], DM, nullptr}; tr_item(S, RmOff{0}, (bf16_t*)(ws + WS_WMOT), DM, 0, (r / 32) * 64, (r % 32) * 32, scr, lane); continue; } r -= I_MO;
        { SrcW S{F.in[19], 2048, F.in[17]}; tr_item(S, RmOff{0}, (bf16_t*)(ws + WS_WMKV), DM, 0, (r / 64) * 64, (r % 64) * 32, scr, lane); }
    }
    {
        const int gt = gw * 64 + lane, NT_ = NGW * 64;
        u32x4 z4 = {0u, 0u, 0u, 0u};
        for (int i = gt; i < 64 * 1024 / 8; i += NT_) *(GAS u32x4*)((bf16_t*)(ws + WS_WIN) + (size_t)448 * DM + (size_t)i * 8) = z4;
        for (int i = gt; i < 1024 * 16; i += NT_) { const int row = i >> 4, ch = i & 15; *(GAS u32x4*)((bf16_t*)(ws + WS_WQKV) + (size_t)(768 + row) * 256 + 128 + ch * 8) = z4; }
        const float* wq = F.in[18]; const float* gq = F.in[16];
        for (int i = gt; i < DM * DM / 8; i += NT_) { const int k = i >> 7; const float g = gq[k];
            const f32x4 a = *(const f32x4*)(wq + (size_t)i * 8), b = *(const f32x4*)(wq + (size_t)i * 8 + 4);
            u32x4 o; o.x = pk2(a[0] * g, a[1] * g); o.y = pk2(a[2] * g, a[3] * g); o.z = pk2(b[0] * g, b[1] * g); o.w = pk2(b[2] * g, b[3] * g);
            *(GAS u32x4*)((bf16_t*)(ws + WS_WMQN) + (size_t)i * 8) = o; }
        const int* pos = (const int*)F.in[2];
        for (int i = gt; i < M * 32; i += NT_) { const int m = i >> 5, j = i & 31;
            double pd_ = 1.0; for (int q = 0; q < j; ++q) pd_ *= 1.3335214321633240257;
            const float fr = 1.0f / (float)pd_;
            const float ang = (float)pos[m] * fr;
            double s, c; sincos_d((double)ang, s, c);
            ((float*)(ws + WS_COS))[i] = (float)c; ((float*)(ws + WS_SIN))[i] = (float)s; }
    }
    for (int m = gw; m < M + 1024; m += NGW) {
        const bool isx = m < M; const int row = isx ? m : m - M;
        const float* src = (isx ? F.in[0] : F.in[1]) + (size_t)row * DM;
        bf16_t* dst = (bf16_t*)(ws + (isx ? WS_HB : WS_MEMB)) + (size_t)row * DM;
        const GAS f32x4* xr = (const GAS f32x4*)src + lane;
        f32x4 v[4]; float s = 0.f;
#pragma unroll
        for (int j = 0; j < 4; ++j) { v[j] = xr[64 * j]; s += (v[j].x * v[j].x + v[j].y * v[j].y) + (v[j].z * v[j].z + v[j].w * v[j].w); }
        s = wave_sum(s);
        GAS unsigned long long* o8 = (GAS unsigned long long*)dst + lane;
#pragma unroll
        for (int j = 0; j < 4; ++j) o8[64 * j] = (unsigned long long)pk2(v[j].x, v[j].y) | ((unsigned long long)pk2(v[j].z, v[j].w) << 32);
        if (lane < 4) { float* st = stat_ptr(ws, isx ? ST_X : ST_MEM); const int sm = isx ? M : 1024; st[lane * sm + row] = (lane == 0) ? s : 0.f; }
    }
}

__device__ __forceinline__ void mix_prep(Frame& F) {
    const int gw = F.vcu * NWAVES + F.wave, NGW = F.G * NWAVES, lane = F.lane;
    const bf16_t* zb = (const bf16_t*)(F.ws + WS_ZB); bf16_t* a2 = (bf16_t*)(F.ws + WS_A2); bf16_t* kpe = (bf16_t*)(F.ws + WS_KPE);
    const float* cosT = (const float*)(F.ws + WS_COS); const float* sinT = (const float*)(F.ws + WS_SIN);
    const int g = lane >> 4, w = 2 << g, c8 = (lane & 15) * 8;
    for (int run = gw; run < M / 64; run += NGW) {
        const int m0 = run * 64, s0 = m0 & (SEQ - 1);
        const bf16_t* zp = zb + 512 + g * 128 + c8;
        float sum[8];
#pragma unroll
        for (int i = 0; i < 8; ++i) sum[i] = 0.f;
        for (int d = 1; d < w; ++d) { if (s0 - d >= 0) { const bf16x8 v = *(const bf16x8*)(zp + (size_t)(m0 - d) * DM);
#pragma unroll
            for (int i = 0; i < 8; ++i) sum[i] += bf2f((unsigned short)v[i]); } }
        for (int rr = 0; rr < 64; ++rr) {
            const int m = m0 + rr, s = s0 + rr;
            const bf16x8 v = *(const bf16x8*)(zp + (size_t)m * DM);
            float zf[8];
#pragma unroll
            for (int i = 0; i < 8; ++i) { zf[i] = bf2f((unsigned short)v[i]); sum[i] += zf[i]; }
            const float inv = 1.0f / (float)((s + 1 < w) ? (s + 1) : w);
            u32x4 o; o.x = cvt_pk_bf16(sum[0] * inv - zf[0], sum[1] * inv - zf[1]); o.y = cvt_pk_bf16(sum[2] * inv - zf[2], sum[3] * inv - zf[3]);
            o.z = cvt_pk_bf16(sum[4] * inv - zf[4], sum[5] * inv - zf[5]); o.w = cvt_pk_bf16(sum[6] * inv - zf[6], sum[7] * inv - zf[7]);
            *(u32x4*)(a2 + (size_t)m * DM + 512 + g * 128 + c8) = o;
            if (s - w + 1 >= 0) { const bf16x8 u = *(const bf16x8*)(zp + (size_t)(m - w + 1) * DM);
#pragma unroll
                for (int i = 0; i < 8; ++i) sum[i] -= bf2f((unsigned short)u[i]); }
            if (lane < 32) { const float x1 = bf2f(zb[(size_t)m * DM + 384 + lane]), x2 = bf2f(zb[(size_t)m * DM + 416 + lane]);
                const float c = cosT[(size_t)m * 32 + lane], sn = sinT[(size_t)m * 32 + lane];
                kpe[(size_t)m * 64 + lane] = (bf16_t)f2bf(x1 * c - x2 * sn); kpe[(size_t)m * 64 + 32 + lane] = (bf16_t)f2bf(x1 * sn + x2 * c); }
        }
    }
}
__device__ __forceinline__ void final_norm(Frame& F) {
    const int gw = F.vcu * NWAVES + F.wave, NGW = F.G * NWAVES, lane = F.lane;
    const float* st = stat_ptr(F.ws, ST_H4); const float* g = F.in[25];
    f32x4 gv[4];
#pragma unroll
    for (int j = 0; j < 4; ++j) gv[j] = *(const f32x4*)(g + 4 * lane + 256 * j);
    for (int m = gw; m < M; m += NGW) {
        const float sc = pg8::rstd_of(st, m, 1.0f / DM);
        GAS f32x4* xr = (GAS f32x4*)(F.out + (size_t)m * DM) + lane;
#pragma unroll
        for (int j = 0; j < 4; ++j) { f32x4 v = xr[64 * j]; v = v * sc * gv[j]; xr[64 * j] = v; }
    }
}

struct GridOrder {
    int nM, nN, G, c; const char* A; const char* B; size_t sa_pm; size_t sb_pn; int a_thr; size_t a_off; int b_shift; size_t sb_b;
    __device__ __forceinline__ bool next(int i, pg8::Unit& u) const {
        int pm, pn; if (!pg8::tile_of(i * G + c, nM, nN, pm, pn)) return false;
        u.pm = pm; u.pn = pn; u.a = A + (size_t)pm * sa_pm + (pn >= a_thr ? a_off : 0); u.b = B + (size_t)pn * sb_pn + (size_t)(pm >> b_shift) * sb_b; u.o = nullptr; return true;
    }
};
struct MemKVOrder {
    int G, c; unsigned char* ws;
    __device__ __forceinline__ bool next(int i, pg8::Unit& u) const {
        const int L = i * G + c; if (L >= 32) return false;
        const int b = L >> 3, pn = L & 7, kv = pn >> 2, h = pn & 3;
        u.pm = b; u.pn = pn; u.a = (const char*)(ws + WS_MEMB) + (size_t)b * 256 * DM * 2; u.b = (const char*)(ws + WS_WMKV) + (size_t)pn * 256 * DM * 2;
        u.o = (char*)(ws + (kv ? WS_VM : WS_KM)) + (size_t)(b * 4 + h) * 256 * 256 * 2; return true;
    }
};
struct WeffOrder {
    int G, c; unsigned char* ws;
    __device__ __forceinline__ bool next(int i, pg8::Unit& u) const {
        const int L = i * G + c; if (L >= 64) return false;
        const int bh = L >> 2, pn = L & 3, b = bh >> 2, h = bh & 3;
        u.pm = 0; u.pn = pn; u.a = (const char*)(ws + WS_KM) + (size_t)bh * 256 * 256 * 2; u.b = (const char*)(ws + WS_WMQN) + ((size_t)pn * 256 * DM + h * 256) * 2;
        u.o = (char*)(ws + WS_WEFF) + (((size_t)b * 1024 + h * 256) * 1024 + pn * 256) * 2; return true;
    }
};
struct WvoOrder {
    int G, c; unsigned char* ws;
    __device__ __forceinline__ bool next(int i, pg8::Unit& u) const {
        const int L = i * G + c; if (L >= 64) return false;
        const int bh = L >> 2, pm = L & 3, b = bh >> 2, h = bh & 3;
        u.pm = 0; u.pn = 0; u.a = (const char*)(ws + WS_WMOT) + ((size_t)pm * 256 * DM + h * 256) * 2; u.b = (const char*)(ws + WS_VM) + (size_t)bh * 256 * 256 * 2;
        u.o = (char*)(ws + WS_WVO) + (((size_t)b * 1024 + pm * 256) * 1024 + h * 256) * 2; return true;
    }
};

struct Args { const float* in[26]; float* out; unsigned char* ws; int ph_lo, ph_hi; };
__global__ void __launch_bounds__(NWAVES * 64, 2) mk_fwd(Args args) {
    extern __shared__ __attribute__((aligned(16))) unsigned char lds[];
    Frame F;
    F.lds = (LAS unsigned char*)lds;
    F.MISC = (volatile LAS unsigned*)(F.lds + MISC_OFF);
    F.tid = threadIdx.x; F.lane = F.tid & 63; F.wave = __builtin_amdgcn_readfirstlane(F.tid >> 6);
    F.G = gridDim.x; { const int bx = blockIdx.x; F.vcu = (F.G % 8 == 0) ? (bx % 8) * (F.G / 8) + bx / 8 : bx; }
    unsigned char* ws = args.ws; F.ws = ws;
    F.ctl = (gu32*)(ws + WS_CTL);
#pragma unroll
    for (int i = 0; i < 26; ++i) F.in[i] = args.in[i];
    F.out = args.out;
    for (int u = F.tid; u < (LDS_BYTES - LDSCTL_OFF) / 4; u += NWAVES * 64) ((LAS unsigned*)(F.lds + LDSCTL_OFF))[u] = 0u;
    __syncthreads();
    XcdBarrier bar; bar.bar = (unsigned*)(F.ctl + CW_BAR); bar.x = 0; bar.st = nullptr;
    if (!MK_PER_PHASE) bar = xcd_barrier_post((unsigned*)(F.ctl + CW_BAR), F.MISC + 8);
#define GRID_BAR() do { if (MK_PER_PHASE) { if (F.tid == 0) __hip_atomic_store(F.ctl + CW_TMO, 0xBADBA0u, RLX_AGENT); } else { xcd_barrier(bar); } } while (0)
    const int lo = args.ph_lo, hi = args.ph_hi;
#ifndef PH_MASK
#define PH_MASK 0xFFFF
#endif
#define IN(k) (lo <= (k) && (k) < hi && ((PH_MASK >> (k)) & 1))
#define BOTH(k) (IN(k) && IN((k) + 1))
    const int G = F.G, c = (int)blockIdx.x;
    const char* HBp = (const char*)(ws + WS_HB);
    using namespace pg8;

    if (IN(0)) { p0_prologue(F); if (BOTH(0)) GRID_BAR(); }

    if (IN(1)) {
        { Gemm g{DM, DM, DM}; GridOrder S{64, 22, G, c, HBp, (const char*)(ws + WS_W1GU), (size_t)256 * DM * 2, (size_t)256 * DM * 2, 1 << 30, 0, 30, 0};
          EpiSwiGLU E{stat_ptr(ws, ST_X), (bf16_t*)(ws + WS_ACT)};
          gemm_phase<EpiSwiGLU, GridOrder, true>(F.lds, g, S, E); }
        { Gemm g{DM, DM, DM}; MemKVOrder S{G, (c + G - 128) % G, ws}; EpiStore E{stat_ptr(ws, ST_MEM), 1.0f / DM, 256, 1024};
          gemm_phase<EpiStore, MemKVOrder, true>(F.lds, g, S, E); }
        if (BOTH(1)) GRID_BAR();
    }
    if (IN(2)) {
        Gemm g{DFF, DFF, DFF}; GridOrder S{64, 4, G, c, (const char*)(ws + WS_ACT), (const char*)(ws + WS_W1D), (size_t)256 * DFF * 2, (size_t)256 * DFF * 2, 1 << 30, 0, 30, 0};
        EpiResid E{F.in[0], F.out, (bf16_t*)(ws + WS_HB), stat_ptr(ws, ST_H1), 0.5f};
        gemm_phase<EpiResid, GridOrder, false>(F.lds, g, S, E);
        if (BOTH(2)) GRID_BAR();
    }
    if (IN(3)) {
        Gemm g{DM, DM, DM}; GridOrder S{64, 4, G, c, HBp, (const char*)(ws + WS_WIN), (size_t)256 * DM * 2, (size_t)256 * DM * 2, 1 << 30, 0, 30, 0};
        EpiZ E{stat_ptr(ws, ST_H1), (bf16_t*)(ws + WS_ZB), stat_ptr(ws, ST_Q), stat_ptr(ws, ST_KV)};
        gemm_phase<EpiZ, GridOrder, true>(F.lds, g, S, E);
        if (BOTH(3)) GRID_BAR();
    }
    if (IN(4)) {
#ifndef P4_SUB
#define P4_SUB 15
#endif
        if (P4_SUB & 1) mix_prep(F);
        if (P4_SUB & 2) { Gemm g{DM, 256, 256}; GridOrder S{64, 7, G, c, (const char*)(ws + WS_ZB), (const char*)(ws + WS_WQKV), (size_t)256 * DM * 2, (size_t)256 * 256 * 2, 3, 256 * 2, 30, 0};
          EpiQKV E{stat_ptr(ws, ST_Q), stat_ptr(ws, ST_KV), (const float*)(ws + WS_COS), (const float*)(ws + WS_SIN), (bf16_t*)(ws + WS_Q), (bf16_t*)(ws + WS_KN), (bf16_t*)(ws + WS_V), 0.07216878364870322f * LOG2E};
          gemm_phase<EpiQKV, GridOrder, true>(F.lds, g, S, E); }
        if (P4_SUB & 4) { Gemm g{256, DM, 256}; WeffOrder S{G, (c + G - 192) % G, ws}; EpiStore E{nullptr, 0.f, 1024, 0};
          gemm_phase<EpiStore, WeffOrder, true>(F.lds, g, S, E); }
        if (P4_SUB & 8) { Gemm g{DM, 256, 256}; WvoOrder S{G, (c + G - 192) % G, ws}; EpiStore E{nullptr, 0.f, 1024, 0};
          gemm_phase<EpiStore, WvoOrder, true>(F.lds, g, S, E); }
        if (BOTH(4)) GRID_BAR();
    }
    if (IN(5)) {
        const int bh = F.vcu >> 4, qb = F.vcu & 15, b = bh >> 2, h = bh & 3;
        if (F.vcu < 256) {
            attn::Blk B;
            B.Q = (const bf16_t*)(ws + WS_Q) + ((size_t)bh * SEQ + qb * 256) * 192;
            B.KN = (const bf16_t*)(ws + WS_KN) + (size_t)bh * SEQ * 128; B.KP = (const bf16_t*)(ws + WS_KPE) + (size_t)b * SEQ * 64; B.V = (const bf16_t*)(ws + WS_V) + (size_t)bh * SEQ * 128;
            B.O = (bf16_t*)(ws + WS_A2) + ((size_t)b * SEQ + qb * 256) * DM + h * 128; B.P0 = qb * 256; B.j_lo = 0; B.j_hi = 4 * (qb + 1);
            B.part = nullptr; B.flag = nullptr; B.tmo = (unsigned*)(F.ctl + CW_TMO);
            attn::block<0>(B, (char*)lds);
        }
        if (BOTH(5)) GRID_BAR();
    }
    if (IN(6)) {
        Gemm g{DM, DM, DM}; GridOrder S{64, 4, G, c, (const char*)(ws + WS_A2), (const char*)(ws + WS_WOUT), (size_t)256 * DM * 2, (size_t)256 * DM * 2, 1 << 30, 0, 30, 0};
        EpiResid E{F.out, F.out, (bf16_t*)(ws + WS_HB), stat_ptr(ws, ST_H2), 1.0f};
        gemm_phase<EpiResid, GridOrder, false>(F.lds, g, S, E);
        if (BOTH(6)) GRID_BAR();
    }
    if (IN(7)) {
        Gemm g{DM, DM, DM}; GridOrder S{64, 4, G, c, HBp, (const char*)(ws + WS_WEFF), (size_t)256 * DM * 2, (size_t)256 * DM * 2, 1 << 30, 0, 4, (size_t)DM * DM * 2};
        EpiSoftmax E{stat_ptr(ws, ST_H2), (bf16_t*)(ws + WS_ZB), 0.0625f * LOG2E};
        gemm_phase<EpiSoftmax, GridOrder, false>(F.lds, g, S, E);
        if (BOTH(7)) GRID_BAR();
    }
    if (IN(8)) {
        Gemm g{DM, DM, DM}; GridOrder S{64, 4, G, c, (const char*)(ws + WS_ZB), (const char*)(ws + WS_WVO), (size_t)256 * DM * 2, (size_t)256 * DM * 2, 1 << 30, 0, 4, (size_t)DM * DM * 2};
        EpiResid E{F.out, F.out, (bf16_t*)(ws + WS_HB), stat_ptr(ws, ST_H3), 1.0f};
        gemm_phase<EpiResid, GridOrder, false>(F.lds, g, S, E);
        if (BOTH(8)) GRID_BAR();
    }
    if (IN(9)) {
        Gemm g{DM, DM, DM}; GridOrder S{64, 22, G, c, HBp, (const char*)(ws + WS_W2GU), (size_t)256 * DM * 2, (size_t)256 * DM * 2, 1 << 30, 0, 30, 0};
        EpiSwiGLU E{stat_ptr(ws, ST_H3), (bf16_t*)(ws + WS_ACT)};
        gemm_phase<EpiSwiGLU, GridOrder, true>(F.lds, g, S, E);
        if (BOTH(9)) GRID_BAR();
    }
    if (IN(10)) {
        Gemm g{DFF, DFF, DFF}; GridOrder S{64, 4, G, c, (const char*)(ws + WS_ACT), (const char*)(ws + WS_W2D), (size_t)256 * DFF * 2, (size_t)256 * DFF * 2, 1 << 30, 0, 30, 0};
        EpiResid E{F.out, F.out, nullptr, stat_ptr(ws, ST_H4), 0.5f};
        gemm_phase<EpiResid, GridOrder, false>(F.lds, g, S, E);
        if (BOTH(10)) GRID_BAR();
    }
    if (IN(11)) { final_norm(F); }
#undef IN
#undef BOTH
#undef GRID_BAR
}

extern "C" void kernel_launch(void* const* d_in, const int* in_sizes, int n_in, void* d_out, int out_size, void* d_ws, size_t ws_size, hipStream_t stream) {
    static int grid = 0;
    if (grid == 0) {
        if (n_in != 26 || in_sizes[0] != M * DM || out_size != M * DM || ws_size < WS_END) {
            fprintf(stderr, "kernel_launch: unexpected shapes: n_in %d, in0 %d, out %d, ws %zu (need >= %zu); nothing launched\n", n_in, n_in > 0 ? in_sizes[0] : -1, out_size, ws_size, (size_t)WS_END); grid = -1; return; }
        int dev = 0, cus = 0;
        if (hipGetDevice(&dev) != hipSuccess || hipDeviceGetAttribute(&cus, hipDeviceAttributeMultiprocessorCount, dev) != hipSuccess) { fprintf(stderr, "kernel_launch: device query failed\n"); grid = -1; return; }
        if (hipFuncSetAttribute((const void*)mk_fwd, hipFuncAttributeMaxDynamicSharedMemorySize, LDS_BYTES) != hipSuccess) { fprintf(stderr, "kernel_launch: hipFuncSetAttribute failed\n"); grid = -1; return; }
        (void)hipGetLastError();
        grid = cus;
        if (grid != 256) fprintf(stderr, "kernel_launch: note: %d CUs (built for 256)\n", grid);
    }
    if (grid < 0) return;
    if (hipMemsetAsync((char*)d_ws + WS_CTL, 0, CTL_ZERO_BYTES, stream) != hipSuccess) { fprintf(stderr, "kernel_launch: memset failed\n"); return; }
    Args a{};
    for (int i = 0; i < 26; ++i) a.in[i] = (const float*)d_in[i];
    a.out = (float*)d_out; a.ws = (unsigned char*)d_ws;
#if MK_PER_PHASE
    for (int p = 0; p < N_PHASES; ++p) { a.ph_lo = p; a.ph_hi = p + 1; hipLaunchKernelGGL(mk_fwd, dim3(grid), dim3(NWAVES * 64), LDS_BYTES, stream, a); }
#else
    a.ph_lo = 0; a.ph_hi = N_PHASES;
    hipLaunchKernelGGL(mk_fwd, dim3(grid), dim3(NWAVES * 64), LDS_BYTES, stream, a);
#endif
    const hipError_t le = hipPeekAtLastError();
    if (le != hipSuccess) fprintf(stderr, "kernel_launch: launch failed: %s\n", hipGetErrorName(le));
}
```

```cpp
#include <hip/hip_runtime.h>
#include <cstdio>
#include <cstdint>

#define LAS __attribute__((address_space(3)))
#define GAS __attribute__((address_space(1)))
typedef unsigned short bf16_t;
typedef short bf16x8 __attribute__((ext_vector_type(8)));
typedef short s16x4 __attribute__((ext_vector_type(4)));
typedef float f32x2 __attribute__((ext_vector_type(2)));
typedef float f32x4 __attribute__((ext_vector_type(4)));
typedef float f32x16 __attribute__((ext_vector_type(16)));
typedef unsigned u32x2 __attribute__((ext_vector_type(2)));
typedef unsigned u32x4 __attribute__((ext_vector_type(4)));

constexpr int DM = 1024, NB = 4, SEQ = 4096, M = NB * SEQ;
constexpr int DFF = 2816, NMEM = 256;
constexpr float RMS_EPS = 1e-6f;
constexpr float LOG2E = 1.4426950408889634f;
constexpr size_t A_WS_Q = 127u << 20, A_WS_KN = 151u << 20, A_WS_V = 167u << 20, A_WS_A2 = 183u << 20, A_WS_KPE = 221u << 20, A_WS_PART = 229u << 20; constexpr int A_CW_AFLAG = 16384;

__device__ __forceinline__ unsigned cvt_pk_bf16(float lo, float hi) { unsigned r; asm volatile("v_cvt_pk_bf16_f32 %0, %1, %2" : "=v"(r) : "v"(lo), "v"(hi)); return r; }
__device__ __forceinline__ int lane_id() { return (int)__builtin_amdgcn_mbcnt_hi(~0u, __builtin_amdgcn_mbcnt_lo(~0u, 0u)); }
__device__ __forceinline__ float bf2f(unsigned short h) { return __uint_as_float((unsigned)h << 16); }

namespace pg8 {
constexpr int BM = 256, BK = 64, HALF = 128, HTB = HALF * BK * 2, STAGE_BYTES = 8 * HTB, NXCD = 8, WGM = 8;
__host__ __device__ __forceinline__ int lds_byte(int r, int c) { const int st = (r >> 4) * 2 + (c >> 5), rr = r & 15, cc = c & 31, ob = rr * 64 + cc * 2; return st * 1024 + (ob ^ (((ob >> 9) & 1) << 5)); }
__host__ __device__ __forceinline__ void stage_rc(int b, int& R, int& C) { const int st = b / 1024, sb = b % 1024, swz = sb ^ (((sb >> 9) & 1) << 5); R = (st >> 1) * 16 + swz / 64; C = (st & 1) * 32 + (swz % 64) / 2; }
__host__ __device__ __forceinline__ int perm32(int rho) { const int n = rho >> 4, i = rho & 15; return 8 * (i >> 2) + 4 * n + (i & 3); }

struct Unit { int pm, pn; const char* a; const char* b; char* o; };
struct Gemm { int lda, ldb, K; };

__device__ __forceinline__ bool tile_of(int L, int nM, int nN, int& pm, int& pn) {
    const int nwg = nM * nN; if (L >= nwg) return false;
    int wgid = L; { const int q = nwg / NXCD, r = nwg % NXCD, xcd = wgid % NXCD, off = wgid / NXCD; wgid = (xcd < r ? xcd * (q + 1) : r * (q + 1) + (xcd - r) * q) + off; }
    const int nig = WGM * nN, gid = wgid / nig, fm = gid * WGM, gsz = (nM - fm) < WGM ? (nM - fm) : WGM;
    pm = fm + ((wgid % nig) % gsz); pn = (wgid % nig) / gsz; return true;
}

template <class Epi, class Sched, bool ALIGN_EPI>
__device__ __forceinline__ void gemm_phase(LAS unsigned char* lds, const int wave, const Gemm g, const Sched& S, const Epi& E) {
    int lane_ = lane_id(); asm volatile("" : "+v"(lane_));
    const int wid = wave, lane = lane_, tid = wid * 64 + lane, wr = wid >> 2, wc = wid & 3, fr = lane & 15, fq = lane >> 4;
    int K_ = g.K; asm volatile("" : "+s"(K_));
    const int nt = K_ / BK;
    unsigned voffA[2], voffB[2];
#pragma unroll
    for (int i = 0; i < 2; ++i) { int R, C; stage_rc(tid * 16 + i * 8192, R, C); const int Rb = Epi::PERM ? ((R & ~31) + perm32(R & 31)) : R;
        voffA[i] = (unsigned)(R * g.lda + C) * 2u; voffB[i] = (unsigned)(Rb * g.ldb + C) * 2u; }
    const size_t kstep = (size_t)(BK * 2);
    const size_t hstepA = (size_t)HALF * g.lda * 2, hstepB = (size_t)HALF * g.ldb * 2;
    const unsigned ldsw = (unsigned)wid * 1024u;
    const int aoff = lds_byte(wr * 64 + fr, fq * 8), boff = lds_byte(wc * 32 + fr, fq * 8);
#define PG8_SA(b, h) (((b) * 2 + (h)) * HTB)
#define PG8_SB(b, h) ((4 + (b) * 2 + (h)) * HTB)
#define PG8_STAGE(bufoff, gbase, voff) do { _Pragma("unroll") for (int _i = 0; _i < 2; ++_i) \
        __builtin_amdgcn_global_load_lds((const unsigned*)((const char*)(gbase) + (voff)[_i]), (LAS unsigned*)(lds + (bufoff) + ldsw + _i * 8192), 16, 0, 0); } while (0)
#define PG8_LDA(dst, b, h) do { _Pragma("unroll") for (int m = 0; m < 4; ++m) _Pragma("unroll") for (int k = 0; k < 2; ++k) dst[m][k] = *(const LAS bf16x8*)(lds + PG8_SA(b, h) + aoff + m * 2048 + k * 1024); } while (0)
#define PG8_LDB(dst, b, h) do { _Pragma("unroll") for (int n = 0; n < 2; ++n) _Pragma("unroll") for (int k = 0; k < 2; ++k) dst[n][k] = *(const LAS bf16x8*)(lds + PG8_SB(b, h) + boff + n * 2048 + k * 1024); } while (0)
#define PG8_MMA(ai, bj, At, Bt) do { __builtin_amdgcn_s_setprio(1); _Pragma("unroll") for (int m = 0; m < 4; ++m) _Pragma("unroll") for (int n = 0; n < 2; ++n) _Pragma("unroll") for (int k = 0; k < 2; ++k) \
        acc[ai][bj][m][n] = __builtin_amdgcn_mfma_f32_16x16x32_bf16(Bt[n][k], At[m][k], acc[ai][bj][m][n], 0, 0, 0); __builtin_amdgcn_s_setprio(0); } while (0)
#define PG8_WAIT_V(n) asm volatile("s_waitcnt vmcnt(" #n ")" ::: "memory")
#define PG8_WAIT_L(n) asm volatile("s_waitcnt lgkmcnt(" #n ")" ::: "memory")
#define PG8_BAR __builtin_amdgcn_s_barrier()
#define PG8_SCHED __builtin_amdgcn_sched_barrier(0)
    Unit cur, nxt; int ui = 0;
    if (!S.next(0, cur)) return;
    f32x4 acc[2][2][4][2];
#pragma unroll
    for (int a = 0; a < 2; ++a)
#pragma unroll
        for (int b = 0; b < 2; ++b)
#pragma unroll
            for (int m = 0; m < 4; ++m)
#pragma unroll
                for (int n = 0; n < 2; ++n) acc[a][b][m][n] = (f32x4){0.f, 0.f, 0.f, 0.f};
    bf16x8 At[4][2], B0[2][2], B1[2][2];
    const char* cA = cur.a; const char* cB = cur.b;
    PG8_STAGE(PG8_SB(0, 0), cB, voffB); PG8_STAGE(PG8_SB(0, 1), cB + hstepB, voffB); PG8_STAGE(PG8_SA(0, 0), cA, voffA); PG8_STAGE(PG8_SA(0, 1), cA + hstepA, voffA);
    if (wr == 1) PG8_BAR;
    PG8_WAIT_V(2); PG8_BAR;
    PG8_STAGE(PG8_SB(1, 0), cB + kstep, voffB); PG8_STAGE(PG8_SA(1, 0), cA + kstep, voffA); PG8_STAGE(PG8_SB(1, 1), cB + hstepB + kstep, voffB);
    PG8_WAIT_V(6); PG8_BAR;
    for (;;) {
        const bool has_next = S.next(ui + 1, nxt);
        const char* nA = has_next ? nxt.a : cA; const char* nB = has_next ? nxt.b : cB;
        for (int t = 0; t < nt; t += 2) {
            const bool last = (t == nt - 2);
            const char* a1 = cA + (size_t)(t + 1) * kstep;
            const char* a2 = last ? nA : cA + (size_t)(t + 2) * kstep; const char* b2 = last ? nB : cB + (size_t)(t + 2) * kstep;
            const char* a3 = a2 + kstep; const char* b3 = b2 + kstep;
            PG8_LDB(B0, 0, 0); PG8_LDB(B1, 0, 1); PG8_SCHED; PG8_LDA(At, 0, 0); PG8_STAGE(PG8_SA(1, 1), a1 + hstepA, voffA);
            PG8_WAIT_V(8); PG8_WAIT_L(0); PG8_BAR; PG8_MMA(0, 0, At, B0); PG8_MMA(0, 1, At, B1); PG8_BAR; PG8_SCHED;
            PG8_LDA(At, 0, 1); PG8_STAGE(PG8_SB(0, 0), b2, voffB); PG8_STAGE(PG8_SB(0, 1), b2 + hstepB, voffB); PG8_STAGE(PG8_SA(0, 0), a2, voffA);
            PG8_WAIT_V(8); PG8_WAIT_L(0); PG8_BAR; PG8_MMA(1, 0, At, B0); PG8_MMA(1, 1, At, B1); PG8_BAR; PG8_SCHED;
            PG8_LDB(B0, 1, 0); PG8_LDB(B1, 1, 1); PG8_SCHED; PG8_LDA(At, 1, 0); PG8_STAGE(PG8_SA(0, 1), a2 + hstepA, voffA);
            PG8_WAIT_V(8); PG8_WAIT_L(0); PG8_BAR; PG8_MMA(0, 0, At, B0); PG8_MMA(0, 1, At, B1); PG8_BAR; PG8_SCHED;
            PG8_LDA(At, 1, 1); PG8_STAGE(PG8_SB(1, 0), b3, voffB); PG8_STAGE(PG8_SB(1, 1), b3 + hstepB, voffB); PG8_STAGE(PG8_SA(1, 0), a3, voffA);
            PG8_WAIT_V(8); PG8_WAIT_L(0); PG8_BAR; PG8_MMA(1, 0, At, B0); PG8_MMA(1, 1, At, B1); PG8_BAR; PG8_SCHED;
        }
        if constexpr (ALIGN_EPI) { if (wr == 0) PG8_BAR; }
        if constexpr (!Epi::AFTER_DRAIN) { E(acc, cur, wr, wc, fr, fq); }
        if (!has_next) break;
#pragma unroll
        for (int a = 0; a < 2; ++a)
#pragma unroll
            for (int b = 0; b < 2; ++b)
#pragma unroll
                for (int m = 0; m < 4; ++m)
#pragma unroll
                    for (int n = 0; n < 2; ++n) acc[a][b][m][n] = (f32x4){0.f, 0.f, 0.f, 0.f};
        cur = nxt; cA = nA; cB = nB; ++ui;
        if constexpr (ALIGN_EPI) { if (wr == 1) PG8_BAR; }
    }
    PG8_WAIT_V(0);
    if constexpr (!ALIGN_EPI) { if (wr == 0) PG8_BAR; }
    PG8_BAR;
    if constexpr (Epi::AFTER_DRAIN) { E.fused(acc, cur, wr, wc, fr, fq, lds, wid, lane); }
#undef PG8_SA
#undef PG8_SB
#undef PG8_STAGE
#undef PG8_LDA
#undef PG8_LDB
#undef PG8_MMA
#undef PG8_WAIT_V
#undef PG8_WAIT_L
#undef PG8_BAR
#undef PG8_SCHED
}

typedef f32x4 Acc[2][2][4][2];

__device__ __forceinline__ float rstd_of(const float* st, int m, float inv) {
    const float s = (st[m] + st[M + m]) + (st[2 * M + m] + st[3 * M + m]);
    return __builtin_amdgcn_rsqf(s * inv + RMS_EPS);
}
__device__ __forceinline__ u32x4 pack8v(f32x4 a, f32x4 b) { u32x4 w; w.x = cvt_pk_bf16(a[0], a[1]); w.y = cvt_pk_bf16(a[2], a[3]); w.z = cvt_pk_bf16(b[0], b[1]); w.w = cvt_pk_bf16(b[2], b[3]); return w; }

struct EpiStore {
    static constexpr bool PERM = true, AFTER_DRAIN = false;
    const float* st; float inv; int ldo; int stM;
    __device__ __forceinline__ void operator()(const Acc& acc, const Unit& u, int wr, int wc, int fr, int fq) const {
        asm volatile("" : "+v"(fr), "+v"(fq));
        bf16_t* base = (bf16_t*)u.o;
#pragma unroll
        for (int ai = 0; ai < 2; ++ai)
#pragma unroll
            for (int m = 0; m < 4; ++m) {
                const int r = ai * HALF + wr * 64 + m * 16 + fr;
                float sc = 1.f;
                if (st) { const int gm = u.pm * BM + r; const float s = (st[gm] + st[stM + gm]) + (st[2 * stM + gm] + st[3 * stM + gm]); sc = __builtin_amdgcn_rsqf(s * inv + RMS_EPS); }
                bf16_t* rowp = base + (size_t)r * ldo + wc * 32 + 8 * fq;
#pragma unroll
                for (int bj = 0; bj < 2; ++bj) *(u32x4*)(rowp + bj * HALF) = pack8v(acc[ai][bj][m][0] * sc, acc[ai][bj][m][1] * sc);
            }
    }
};

struct EpiSwiGLU {
    static constexpr bool PERM = true, AFTER_DRAIN = false;
    const float* st; bf16_t* act;
    __device__ __forceinline__ void operator()(const Acc& acc, const Unit& u, int wr, int wc, int fr, int fq) const {
        asm volatile("" : "+v"(fr), "+v"(fq));
#pragma unroll
        for (int ai = 0; ai < 2; ++ai)
#pragma unroll
            for (int m = 0; m < 4; ++m) {
                const int gm = u.pm * BM + ai * HALF + wr * 64 + m * 16 + fr;
                const float sc = rstd_of(st, gm, 1.0f / DM);
                f32x4 o[2];
#pragma unroll
                for (int n = 0; n < 2; ++n) { const f32x4 gv = acc[ai][0][m][n] * sc, uv = acc[ai][1][m][n] * sc;
#pragma unroll
                    for (int i = 0; i < 4; ++i) { const float e = __builtin_amdgcn_exp2f(-gv[i] * LOG2E); o[n][i] = gv[i] * uv[i] * __builtin_amdgcn_rcpf(1.0f + e); } }
                *(u32x4*)(act + (size_t)gm * DFF + u.pn * HALF + wc * 32 + 8 * fq) = pack8v(o[0], o[1]);
            }
    }
};

struct EpiZ {
    static constexpr bool PERM = true, AFTER_DRAIN = false;
    const float* st; bf16_t* zb; float* statq; float* statkv;
    __device__ __forceinline__ void operator()(const Acc& acc, const Unit& u, int wr, int wc, int fr, int fq) const {
        asm volatile("" : "+v"(fr), "+v"(fq));
#pragma unroll
        for (int ai = 0; ai < 2; ++ai)
#pragma unroll
            for (int m = 0; m < 4; ++m) {
                const int gm = u.pm * BM + ai * HALF + wr * 64 + m * 16 + fr;
                const float sc = rstd_of(st, gm, 1.0f / DM);
                float q0 = 0.f, q1 = 0.f;
#pragma unroll
                for (int bj = 0; bj < 2; ++bj) { const f32x4 v0 = acc[ai][bj][m][0] * sc, v1 = acc[ai][bj][m][1] * sc;
                    const float q = (v0[0] * v0[0] + v0[1] * v0[1]) + (v0[2] * v0[2] + v0[3] * v0[3]) + (v1[0] * v1[0] + v1[1] * v1[1]) + (v1[2] * v1[2] + v1[3] * v1[3]);
                    if (bj == 0) q0 = q; else q1 = q;
                    *(u32x4*)(zb + (size_t)gm * DM + u.pn * BM + bj * HALF + wc * 32 + 8 * fq) = pack8v(v0, v1); }
                if (u.pn < 2) {
                    float q = (u.pn == 0) ? (q0 + q1) : q0;
                    q += __shfl_xor(q, 16); q += __shfl_xor(q, 32);
                    if (fq == 0) { float* d = (u.pn == 0) ? statq : statkv; d[wc * M + gm] = q; }
                }
            }
    }
};

struct EpiQKV {
    static constexpr bool PERM = true, AFTER_DRAIN = false;
    const float* statq; const float* statkv; const float* cosT; const float* sinT; bf16_t* Q; bf16_t* KN; bf16_t* V; float qscale;
    __device__ __forceinline__ void operator()(const Acc& acc, const Unit& u, int wr, int wc, int fr, int fq) const {
        asm volatile("" : "+v"(fr), "+v"(fq));
        const int c8 = 8 * fq;
        if (u.pn < 2) {
#pragma unroll
            for (int ai = 0; ai < 2; ++ai)
#pragma unroll
                for (int m = 0; m < 4; ++m) {
                    const int gm = u.pm * BM + ai * HALF + wr * 64 + m * 16 + fr; const int b = gm >> 12, s = gm & (SEQ - 1);
                    const float sc = rstd_of(statq, gm, 1.0f / 256.0f) * qscale;
#pragma unroll
                    for (int bj = 0; bj < 2; ++bj) { const int h = 2 * u.pn + bj;
                        *(u32x4*)(Q + ((size_t)(b * 4 + h) * SEQ + s) * 192 + wc * 32 + c8) = pack8v(acc[ai][bj][m][0] * sc, acc[ai][bj][m][1] * sc); }
                }
        } else if (u.pn == 2) {
#pragma unroll
            for (int ai = 0; ai < 2; ++ai)
#pragma unroll
                for (int m = 0; m < 4; ++m) {
                    const int gm = u.pm * BM + ai * HALF + wr * 64 + m * 16 + fr; const int b = gm >> 12, s = gm & (SEQ - 1);
                    const float sc = rstd_of(statq, gm, 1.0f / 256.0f) * qscale;
                    bf16_t* qp = Q + ((size_t)(b * 4 + wc) * SEQ + s) * 192 + 128 + c8;
#pragma unroll
                    for (int n = 0; n < 2; ++n) {
                        const f32x4 cv = *(const f32x4*)(cosT + (size_t)gm * 32 + c8 + 4 * n) * sc, sv = *(const f32x4*)(sinT + (size_t)gm * 32 + c8 + 4 * n) * sc;
                        const f32x4 x1 = acc[ai][0][m][n], x2 = acc[ai][1][m][n];
                        const f32x4 o1 = x1 * cv - x2 * sv, o2 = x1 * sv + x2 * cv;
                        u32x2 w1, w2; w1.x = cvt_pk_bf16(o1[0], o1[1]); w1.y = cvt_pk_bf16(o1[2], o1[3]); w2.x = cvt_pk_bf16(o2[0], o2[1]); w2.y = cvt_pk_bf16(o2[2], o2[3]);
                        *(u32x2*)(qp + 4 * n) = w1; *(u32x2*)(qp + 32 + 4 * n) = w2;
                    }
                    asm volatile("" ::: "memory");
                }
        } else {
            const int h = u.pn - 3;
#pragma unroll
            for (int ai = 0; ai < 2; ++ai)
#pragma unroll
                for (int m = 0; m < 4; ++m) {
                    const int gm = u.pm * BM + ai * HALF + wr * 64 + m * 16 + fr; const int b = gm >> 12, s = gm & (SEQ - 1);
                    const float sc = rstd_of(statkv, gm, 1.0f / 128.0f);
                    const size_t off = ((size_t)(b * 4 + h) * SEQ + s) * 128 + wc * 32 + c8;
                    *(u32x4*)(KN + off) = pack8v(acc[ai][0][m][0] * sc, acc[ai][0][m][1] * sc);
                    *(u32x4*)(V + off) = pack8v(acc[ai][1][m][0] * sc, acc[ai][1][m][1] * sc);
                }
        }
    }
};

struct EpiResid {
    static constexpr bool PERM = false, AFTER_DRAIN = true;
    const float* hin; float* hout; bf16_t* hb; float* stat; float alpha;
    __device__ __forceinline__ void fused(Acc& acc, const Unit& u, int wr, int wc, int fr, int fq, LAS unsigned char* lds, int wid, int lane) const {
        asm volatile("" : "+v"(fr), "+v"(fq));
        LAS float* P = (LAS float*)lds;
        const int col0 = u.pn * BM + wc * 32 + 4 * fq;
#pragma unroll
        for (int ai = 0; ai < 2; ++ai)
#pragma unroll
            for (int m = 0; m < 4; ++m) {
                const int r = ai * HALF + wr * 64 + m * 16 + fr; const size_t off = (size_t)(u.pm * BM + r) * DM + col0;
                float q = 0.f;
#pragma unroll
                for (int bj = 0; bj < 2; ++bj)
#pragma unroll
                    for (int n = 0; n < 2; ++n) { const f32x4 bs = *(const f32x4*)(hin + off + bj * HALF + n * 16); const f32x4 o = bs + acc[ai][bj][m][n] * alpha;
                        *(f32x4*)(hout + off + bj * HALF + n * 16) = o;
                        if (hb) { u32x2 w; w.x = cvt_pk_bf16(o[0], o[1]); w.y = cvt_pk_bf16(o[2], o[3]); *(u32x2*)(hb + off + bj * HALF + n * 16) = w; }
                        q += (o[0] * o[0] + o[1] * o[1]) + (o[2] * o[2] + o[3] * o[3]); }
                q += __shfl_xor(q, 16); q += __shfl_xor(q, 32);
                if (fq == 0) P[r * 4 + wc] = q;
            }
        asm volatile("s_waitcnt lgkmcnt(0)" ::: "memory"); __builtin_amdgcn_s_barrier(); asm volatile("" ::: "memory");
        const int t = wid * 64 + lane;
        if (t < 256) { const float s = (P[t * 4 + 0] + P[t * 4 + 1]) + (P[t * 4 + 2] + P[t * 4 + 3]); stat[u.pn * M + u.pm * BM + t] = s; }
        asm volatile("s_waitcnt lgkmcnt(0)" ::: "memory"); __builtin_amdgcn_s_barrier(); asm volatile("" ::: "memory");
    }
};

struct EpiSoftmax {
    static constexpr bool PERM = true, AFTER_DRAIN = true;
    const float* st; bf16_t* Pout; float scale;
    __device__ __forceinline__ void fused(Acc& acc, const Unit& u, int wr, int wc, int fr, int fq, LAS unsigned char* lds, int wid, int lane) const {
        asm volatile("" : "+v"(fr), "+v"(fq));
        LAS f32x2* X = (LAS f32x2*)lds;
#pragma unroll
        for (int ai = 0; ai < 2; ++ai)
#pragma unroll
            for (int m = 0; m < 4; ++m) {
                const int r = ai * HALF + wr * 64 + m * 16 + fr;
                const float sc = rstd_of(st, u.pm * BM + r, 1.0f / DM) * scale;
                float mx = -3.0e38f;
#pragma unroll
                for (int bj = 0; bj < 2; ++bj)
#pragma unroll
                    for (int n = 0; n < 2; ++n) { acc[ai][bj][m][n] = acc[ai][bj][m][n] * sc; const f32x4 v = acc[ai][bj][m][n]; mx = fmaxf(mx, fmaxf(fmaxf(v[0], v[1]), fmaxf(v[2], v[3]))); }
                mx = fmaxf(mx, __shfl_xor(mx, 16)); mx = fmaxf(mx, __shfl_xor(mx, 32));
                float sum = 0.f;
#pragma unroll
                for (int bj = 0; bj < 2; ++bj)
#pragma unroll
                    for (int n = 0; n < 2; ++n) { f32x4 v = acc[ai][bj][m][n];
#pragma unroll
                        for (int i = 0; i < 4; ++i) { v[i] = __builtin_amdgcn_exp2f(v[i] - mx); sum += v[i]; }
                        acc[ai][bj][m][n] = v; }
                sum += __shfl_xor(sum, 16); sum += __shfl_xor(sum, 32);
                if (fq == 0) X[r * 4 + wc] = (f32x2){mx, sum};
            }
        asm volatile("s_waitcnt lgkmcnt(0)" ::: "memory"); __builtin_amdgcn_s_barrier(); asm volatile("" ::: "memory");
#pragma unroll
        for (int ai = 0; ai < 2; ++ai)
#pragma unroll
            for (int m = 0; m < 4; ++m) {
                const int r = ai * HALF + wr * 64 + m * 16 + fr;
                const f32x2 a = X[r * 4 + 0], b = X[r * 4 + 1], c = X[r * 4 + 2], d = X[r * 4 + 3];
                const float mt = fmaxf(fmaxf(a.x, b.x), fmaxf(c.x, d.x));
                const float l = (a.y * __builtin_amdgcn_exp2f(a.x - mt) + b.y * __builtin_amdgcn_exp2f(b.x - mt)) + (c.y * __builtin_amdgcn_exp2f(c.x - mt) + d.y * __builtin_amdgcn_exp2f(d.x - mt));
                const f32x2 mine = X[r * 4 + wc];
                const float f = __builtin_amdgcn_exp2f(mine.x - mt) * __builtin_amdgcn_rcpf(l);
                bf16_t* rowp = Pout + (size_t)(u.pm * BM + r) * DM + u.pn * BM + wc * 32 + 8 * fq;
#pragma unroll
                for (int bj = 0; bj < 2; ++bj) *(u32x4*)(rowp + bj * HALF) = pack8v(acc[ai][bj][m][0] * f, acc[ai][bj][m][1] * f);
            }
        asm volatile("s_waitcnt lgkmcnt(0)" ::: "memory"); __builtin_amdgcn_s_barrier(); asm volatile("" ::: "memory");
    }
};
}
namespace attn {
constexpr int NW = 8, QBLK = 32, KVBLK = 64, QB = NW * QBLK;
constexpr int SHM_V = KVBLK * 128 * 2, SHM_KN = KVBLK * 128 * 2;
constexpr int OFF_V = 0, OFF_KN = 2 * SHM_V, OFF_KP = OFF_KN + 2 * SHM_KN, OFF_WS = OFF_KP + 16384, LDS_BYTES = OFF_WS + NW * 64 * 4;
constexpr float THR = 8.f;

#define KSWZ(row, colB) ((row) * 256 + ((colB) ^ (((row) & 7) << 4)))
#define SBAR() __builtin_amdgcn_sched_barrier(0)
__device__ __forceinline__ int v_st(int k, int c) { const int kk = (k & ~0xC) | ((k & 4) << 1) | ((k & 8) >> 1); return ((kk >> 3) * 4 + (c >> 5)) * 512 + ((kk & 7) * 32 + (c & 31)) * 2; }
__device__ __forceinline__ int v_rd_base(int lane) { return ((lane & 3) << 3) | (((lane >> 2) & 3) << 6) | (((lane >> 4) & 1) << 5) | (((lane >> 5) & 1) << 8); }
constexpr int v_rd_off(int d0, int ks, int half) { return d0 * 512 + ks * 4096 + half * 2048; }
__device__ __forceinline__ int crow(int r, int hi) { return (r & 3) + 8 * (r >> 2) + 4 * hi; }
__device__ __forceinline__ unsigned cvtpk(float lo, float hi) { unsigned r; asm volatile("v_cvt_pk_bf16_f32 %0, %1, %2" : "=v"(r) : "v"(lo), "v"(hi)); return r; }
__device__ __forceinline__ bf16x8 load8(const bf16_t* p) { return *reinterpret_cast<const bf16x8*>(p); }

__device__ __forceinline__ void mask_tile(f32x16& p0, f32x16& p1, int dq) {
    const float NEG = -__builtin_inff();
#pragma unroll
    for (int r = 0; r < 16; ++r) {
        const int c = (r & 3) + 8 * (r >> 2);
        if (dq - c < 0) p0[r] = NEG;
        if (dq - c - 32 < 0) p1[r] = NEG;
    }
}
__device__ __forceinline__ void partialSM(f32x16& p0, f32x16& p1, float& m_reg, float& mn, float& alpha) {
    float pmax = p0[0]; for (int r = 1; r < 16; ++r) pmax = fmaxf(pmax, p0[r]); for (int r = 0; r < 16; ++r) pmax = fmaxf(pmax, p1[r]);
    { auto rr = __builtin_amdgcn_permlane32_swap(__float_as_uint(pmax), __float_as_uint(pmax), false, false);
      pmax = fmaxf(__uint_as_float(rr[0]), __uint_as_float(rr[1])); }
    if (__builtin_expect(__all((pmax - m_reg) <= THR), 1)) { mn = m_reg; alpha = 1.f; }
    else { mn = fmaxf(m_reg, pmax); alpha = __builtin_amdgcn_exp2f(m_reg - mn); m_reg = mn; }
    for (int r = 0; r < 16; ++r) p0[r] = p0[r] - mn; for (int r = 0; r < 16; ++r) p1[r] = p1[r] - mn;
    for (int r = 0; r < 16; ++r) p0[r] = __builtin_amdgcn_exp2f(p0[r]);
}
__device__ __forceinline__ void finishSM(f32x16& p0, f32x16& p1, float alpha, float& l_reg, bf16x8& pa0, bf16x8& pa1, bf16x8& pa2, bf16x8& pa3) {
    for (int r = 0; r < 16; ++r) p1[r] = __builtin_amdgcn_exp2f(p1[r]);
    float ps = 0; for (int r = 0; r < 16; ++r) ps += p0[r]; for (int r = 0; r < 16; ++r) ps += p1[r];
    { auto rr = __builtin_amdgcn_permlane32_swap(__float_as_uint(ps), __float_as_uint(ps), false, false);
      ps = __uint_as_float(rr[0]) + __uint_as_float(rr[1]); }
    l_reg = l_reg * alpha + ps;
#define PK4(P, B_, OUT) do { unsigned a0 = cvtpk(P[B_+0], P[B_+1]), a1 = cvtpk(P[B_+2], P[B_+3]);                          \
        unsigned b0 = cvtpk(P[B_+4], P[B_+5]), b1 = cvtpk(P[B_+6], P[B_+7]);                                             \
        auto r0 = __builtin_amdgcn_permlane32_swap(a0, b0, false, false); auto r1 = __builtin_amdgcn_permlane32_swap(a1, b1, false, false); \
        u32x4 w = {r0[0], r1[0], r0[1], r1[1]}; OUT = *reinterpret_cast<bf16x8*>(&w); } while (0)
    PK4(p0, 0, pa0); PK4(p0, 8, pa1); PK4(p1, 0, pa2); PK4(p1, 8, pa3);
#undef PK4
}
template <int KB>
__device__ __forceinline__ void qkt(f32x16& p0, f32x16& p1, const char* lds, int r32, int hi, const bf16x8* qr) {
    p0 = f32x16{}; p1 = f32x16{};
    const char* kb[4];
#pragma unroll
    for (int dd = 0; dd < 4; ++dd) kb[dd] = lds + OFF_KN + KB * SHM_KN + KSWZ(r32, (dd * 16 + hi * 8) * 2);
#pragma unroll
    for (int d0 = 0; d0 < 8; ++d0) { const char* a = kb[d0 & 3] + (d0 >> 2) * 128;
        bf16x8 b0 = *reinterpret_cast<const bf16x8*>(a);
        bf16x8 b1 = *reinterpret_cast<const bf16x8*>(a + 32 * 256);
        p0 = __builtin_amdgcn_mfma_f32_32x32x16_bf16(b0, qr[d0], p0, 0, 0, 0);
        p1 = __builtin_amdgcn_mfma_f32_32x32x16_bf16(b1, qr[d0], p1, 0, 0, 0); }
#pragma unroll
    for (int d0 = 0; d0 < 4; ++d0) { const char* a = kb[d0] + (OFF_KP - OFF_KN - KB * SHM_KN + KB * 128);
        bf16x8 b0 = *reinterpret_cast<const bf16x8*>(a);
        bf16x8 b1 = *reinterpret_cast<const bf16x8*>(a + 32 * 256);
        p0 = __builtin_amdgcn_mfma_f32_32x32x16_bf16(b0, qr[8 + d0], p0, 0, 0, 0);
        p1 = __builtin_amdgcn_mfma_f32_32x32x16_bf16(b1, qr[8 + d0], p1, 0, 0, 0); }
}
template <int VB>
__device__ __forceinline__ void pv_tile(f32x16* o, int vb0, bf16x8 pa0, bf16x8 pa1, bf16x8 pa2, bf16x8 pa3) {
#define TRRD(dst, off) asm volatile("ds_read_b64_tr_b16 %0, %1 offset:%2" : "=&v"(dst) : "v"(vb0), "i"(off) : "memory")
#define PV_D0(d0) do { s16x4 l0, l1, l2, l3, h0, h1, h2, h3; constexpr int b_ = VB * SHM_V + v_rd_off(d0, 0, 0); \
        TRRD(l0, b_); TRRD(h0, b_ + 2048); TRRD(l1, b_ + 4096); TRRD(h1, b_ + 6144); TRRD(l2, b_ + 8192); TRRD(h2, b_ + 10240); TRRD(l3, b_ + 12288); TRRD(h3, b_ + 14336); \
        asm volatile("s_waitcnt lgkmcnt(0)" ::: "memory"); SBAR();   \
        o[d0] = __builtin_amdgcn_mfma_f32_32x32x16_bf16(pa0, (bf16x8){l0[0], l0[1], l0[2], l0[3], h0[0], h0[1], h0[2], h0[3]}, o[d0], 0, 0, 0);   \
        o[d0] = __builtin_amdgcn_mfma_f32_32x32x16_bf16(pa1, (bf16x8){l1[0], l1[1], l1[2], l1[3], h1[0], h1[1], h1[2], h1[3]}, o[d0], 0, 0, 0);   \
        o[d0] = __builtin_amdgcn_mfma_f32_32x32x16_bf16(pa2, (bf16x8){l2[0], l2[1], l2[2], l2[3], h2[0], h2[1], h2[2], h2[3]}, o[d0], 0, 0, 0);   \
        o[d0] = __builtin_amdgcn_mfma_f32_32x32x16_bf16(pa3, (bf16x8){l3[0], l3[1], l3[2], l3[3], h3[0], h3[1], h3[2], h3[3]}, o[d0], 0, 0, 0); } while (0)
    PV_D0(0); PV_D0(1); PV_D0(2); PV_D0(3);
#undef PV_D0
#undef TRRD
}

struct Blk { unsigned char* ws; unsigned* ctl; int bh, qb, j_lo, j_hi, pairid; };
template <int MODE>
__device__ __forceinline__ void block(const Blk& cur, const int wave, char* lds) {
    int lane_ = lane_id(); asm volatile("" : "+v"(lane_));
    const int wid = wave, lane = lane_, tid = wid * 64 + lane, r32 = lane & 31, hi = lane >> 5;
    const int j_lo = cur.j_lo, NT = cur.j_hi - cur.j_lo, P0 = cur.qb * QB;
    const int qlo = P0 + wid * QBLK, qm = qlo + r32 - 4 * hi;
    char* V_lds = lds + OFF_V; char* KN_lds = lds + OFF_KN; char* KP_lds = lds + OFF_KP;
    float* ws = (float*)(lds + OFF_WS) + wid * 64; float* li_l = ws, * al_l = ws + 32;
    float m_reg = -1e30f, l_reg = 0; f32x16 o[4] = {};
    const int sr = tid >> 4, sc = (tid & 15) * 8, vst0 = v_st(sr, sc), vst1 = v_st(32 + sr, sc), kws = KSWZ(sr, sc * 2);
    const int pr = tid >> 3, pc = (tid & 7) * 8, kpw = KSWZ(pr, pc * 2);
    const int vb0 = (int)(uintptr_t)V_lds + v_rd_base(lane);
    const bf16_t* Kh = (const bf16_t*)(cur.ws + A_WS_KN) + (size_t)cur.bh * SEQ * 128; const bf16_t* Kp = (const bf16_t*)(cur.ws + A_WS_KPE) + (size_t)(cur.bh >> 2) * SEQ * 64; const bf16_t* Vh = (const bf16_t*)(cur.ws + A_WS_V) + (size_t)cur.bh * SEQ * 128;
    bf16x8 st_v0, st_v1, st_k0, st_k1, st_k2;
    bf16x8 qr[12];
#define RESC(a) do { if (__any((a) < 1.f)) { if (hi == 0) al_l[r32] = (a); asm volatile("s_waitcnt lgkmcnt(0)" ::: "memory");              \
                     for (int d_ = 0; d_ < 4; ++d_) for (int r = 0; r < 16; ++r) o[d_][r] *= al_l[crow(r, hi)]; } } while (0)
#define KBASE(t) ((j_lo + (t)) * KVBLK)
#define MASKT(P0_, P1_, t) do { const int kb_ = KBASE(t); if (kb_ + KVBLK - 1 > qlo) mask_tile(P0_, P1_, qm - kb_); } while (0)
#define VMW() asm volatile("s_waitcnt vmcnt(0)" ::: "memory")
#define SLOAD(k0) do { st_v0 = load8(Vh + (size_t)((k0) + sr) * 128 + sc); st_v1 = load8(Vh + (size_t)((k0) + 32 + sr) * 128 + sc);              \
                       st_k0 = load8(Kh + (size_t)((k0) + sr) * 128 + sc); st_k1 = load8(Kh + (size_t)((k0) + 32 + sr) * 128 + sc);              \
                       st_k2 = load8(Kp + (size_t)((k0) + pr) * 64 + pc); } while (0)
#define SWRITE_K(bf) do { *(bf16x8*)(KN_lds + (bf) * SHM_KN + kws) = st_k0; *(bf16x8*)(KN_lds + (bf) * SHM_KN + kws + 32 * 256) = st_k1; *(bf16x8*)(KP_lds + (bf) * 128 + kpw) = st_k2; } while (0)
#define SWRITE_V(bf) do { *(bf16x8*)(V_lds + (bf) * SHM_V + vst0) = st_v0; *(bf16x8*)(V_lds + (bf) * SHM_V + vst1) = st_v1; } while (0)
#pragma unroll
    for (int d0 = 0; d0 < 12; ++d0) qr[d0] = load8((const bf16_t*)(cur.ws + A_WS_Q) + ((size_t)cur.bh * SEQ + P0 + wid * QBLK + r32) * 192 + d0 * 16 + hi * 8);
    SLOAD(KBASE(0)); VMW(); SWRITE_K(0); SWRITE_V(0); SBAR();
    __syncthreads();
    f32x16 pA0, pA1, pB0, pB1; float mnA, mnB, alA, alB; bf16x8 pa0, pa1, pa2, pa3;
    if (NT > 1) SLOAD(KBASE(1));
    SBAR(); qkt<0>(pA0, pA1, lds, r32, hi, qr);
    MASKT(pA0, pA1, 0); partialSM(pA0, pA1, m_reg, mnA, alA);
    if (NT > 1) { VMW(); SWRITE_K(1); SWRITE_V(1); }
    __syncthreads();
#define HALF_STEP(PX0, PX1, mnX, alX, PY0, PY1, alY, t, KB, VB, SB) do {                                                      \
        SBAR(); qkt<KB>(PX0, PX1, lds, r32, hi, qr);                                                                          \
        finishSM(PY0, PY1, alY, l_reg, pa0, pa1, pa2, pa3); SBAR();                                                           \
        if ((t) + 1 < NT) { SLOAD(KBASE((t) + 1)); SBAR(); }                                                                  \
        pv_tile<VB>(o, vb0, pa0, pa1, pa2, pa3); MASKT(PX0, PX1, (t)); partialSM(PX0, PX1, m_reg, mnX, alX);                  \
        __syncthreads();                                                                                                      \
        if ((t) + 1 < NT) { VMW(); SWRITE_K(SB); SWRITE_V(SB); }                                                              \
        RESC(alX); __syncthreads(); } while (0)
    for (int t = 1; t + 1 < NT; t += 2) {
        HALF_STEP(pB0, pB1, mnB, alB, pA0, pA1, alA, t, 1, 0, 0);
        HALF_STEP(pA0, pA1, mnA, alA, pB0, pB1, alB, t + 1, 0, 1, 1);
    }
    const bool even = (NT & 1) == 0;
    if (even) { SBAR(); qkt<1>(pB0, pB1, lds, r32, hi, qr); SBAR(); }
    finishSM(pA0, pA1, alA, l_reg, pa0, pa1, pa2, pa3); SBAR();
    pv_tile<0>(o, vb0, pa0, pa1, pa2, pa3);
    if (even) { MASKT(pB0, pB1, NT - 1); partialSM(pB0, pB1, m_reg, mnB, alB); __syncthreads(); RESC(alB);
        finishSM(pB0, pB1, alB, l_reg, pa0, pa1, pa2, pa3); SBAR(); pv_tile<1>(o, vb0, pa0, pa1, pa2, pa3); }
    SBAR();
    if constexpr (MODE == 1) {
        float* pp = (float*)(cur.ws + A_WS_PART) + (size_t)cur.pairid * (8 * 66 * 64) + (size_t)wid * (66 * 64) + lane;
#pragma unroll
        for (int d0 = 0; d0 < 4; ++d0)
#pragma unroll
            for (int r = 0; r < 16; ++r) pp[(d0 * 16 + r) * 64] = o[d0][r];
        pp[64 * 64] = m_reg; pp[65 * 64] = l_reg;
        asm volatile("s_waitcnt vmcnt(0)" ::: "memory");
        __syncthreads();
        if (tid == 0) { __builtin_amdgcn_fence(__ATOMIC_RELEASE, "agent"); asm volatile("s_waitcnt vmcnt(0)" ::: "memory");
            __hip_atomic_store(cur.ctl + A_CW_AFLAG + 64 * cur.pairid, 1u, __ATOMIC_RELAXED, __HIP_MEMORY_SCOPE_AGENT); }
    } else {
        float f_own, f_oth = 0.f;
        const float* part = (const float*)(cur.ws + A_WS_PART) + (size_t)cur.pairid * (8 * 66 * 64) + (size_t)wid * (66 * 64) + lane;
        if constexpr (MODE == 2) {
            if (tid == 0) { unsigned sp = 0; unsigned* flag = cur.ctl + A_CW_AFLAG + 64 * cur.pairid;
                while (__hip_atomic_load(flag, __ATOMIC_RELAXED, __HIP_MEMORY_SCOPE_AGENT) == 0u) { __builtin_amdgcn_s_sleep(2);
                    if ((++sp & 255u) == 0u) { if (__hip_atomic_load(cur.ctl, __ATOMIC_RELAXED, __HIP_MEMORY_SCOPE_AGENT)) break; if (sp > (1u << 20)) { atomicAdd(cur.ctl, 1u); break; } } }
                __builtin_amdgcn_fence(__ATOMIC_ACQUIRE, "agent"); asm volatile("s_waitcnt vmcnt(0)" ::: "memory"); }
            __syncthreads();
            const float m1 = part[64 * 64], l1 = part[65 * 64];
            const float mt = fmaxf(m1, m_reg), a1 = __builtin_amdgcn_exp2f(m1 - mt), a2 = __builtin_amdgcn_exp2f(m_reg - mt);
            const float inv = __builtin_amdgcn_rcpf(l1 * a1 + l_reg * a2);
            f_own = a2 * inv; f_oth = a1 * inv;
        } else { f_own = __builtin_amdgcn_rcpf(l_reg); }
        if (hi == 0) { li_l[r32] = f_own; al_l[r32] = f_oth; } asm volatile("s_waitcnt lgkmcnt(0)" ::: "memory");
        bf16_t* Ow = (bf16_t*)(cur.ws + A_WS_A2) + ((size_t)(cur.bh >> 2) * SEQ + P0 + wid * QBLK) * DM + (cur.bh & 3) * 128;
#pragma unroll
        for (int r = 0; r < 16; ++r) { const int orow = crow(r, hi); const float fo = li_l[orow]; const float fp = al_l[orow];
#pragma unroll
            for (int d0 = 0; d0 < 4; ++d0) { float v = o[d0][r] * fo;
                if constexpr (MODE == 2) { v += part[(d0 * 16 + r) * 64] * fp; }
                const float vn = __shfl_xor(v, 1);
                if ((r32 & 1) == 0) *(unsigned*)(Ow + (size_t)orow * DM + d0 * 32 + r32) = cvtpk(v, vn); }
            asm volatile("" ::: "memory"); }
    }
    __syncthreads();
#undef RESC
#undef KBASE
#undef MASKT
#undef VMW
#undef SLOAD
#undef SWRITE_K
#undef SWRITE_V
#undef HALF_STEP
}
#undef KSWZ
#undef SBAR
}
constexpr int NWAVES = 8, GRID = 256;
#ifndef MK_PER_PHASE
#define MK_PER_PHASE 0
#endif
constexpr int N_PHASES = 12;

constexpr size_t MiB = 1u << 20;
constexpr size_t WS_CTL = 0, CTL_ZERO_BYTES = 1 * MiB;
constexpr size_t WS_W1GU = 1 * MiB;
constexpr size_t WS_W1D  = 12 * MiB;
constexpr size_t WS_W2GU = WS_W1D + 11 * MiB / 2;
constexpr size_t WS_W2D  = WS_W2GU + 11 * MiB;
constexpr size_t WS_WIN  = 34 * MiB;
constexpr size_t WS_WQKV = 36 * MiB;
constexpr size_t WS_WOUT = 37 * MiB;
constexpr size_t WS_WMQN = 39 * MiB;
constexpr size_t WS_WMOT = 41 * MiB;
constexpr size_t WS_WMKV = 43 * MiB;
constexpr size_t WS_WEFF = 47 * MiB;
constexpr size_t WS_WVO  = 55 * MiB;
constexpr size_t WS_HB   = 63 * MiB;
constexpr size_t WS_ACT  = 95 * MiB;
constexpr size_t WS_ZB   = 95 * MiB;
constexpr size_t WS_Q    = 127 * MiB;
constexpr size_t WS_KN   = 151 * MiB;
constexpr size_t WS_V    = 167 * MiB;
constexpr size_t WS_A2   = 183 * MiB;
constexpr size_t WS_KM   = 215 * MiB;
constexpr size_t WS_VM   = 217 * MiB;
constexpr size_t WS_MEMB = 219 * MiB;
constexpr size_t WS_KPE  = 221 * MiB;
constexpr size_t WS_COS  = 223 * MiB;
constexpr size_t WS_SIN  = 225 * MiB;
constexpr size_t WS_STAT = 227 * MiB;
constexpr size_t STAT_BYTES = 4 * (size_t)M * 4;
constexpr size_t WS_PART = 229 * MiB;
constexpr size_t WS_WOUTP = 246 * MiB;
constexpr size_t WS_BTPOOL = 247 * MiB;
constexpr size_t WS_END  = 248 * MiB;
static_assert(A_WS_Q == WS_Q && A_WS_KN == WS_KN && A_WS_V == WS_V && A_WS_A2 == WS_A2 && A_WS_KPE == WS_KPE && A_WS_PART == WS_PART, "attention body offsets");
enum { ST_X = 0, ST_H1, ST_H2, ST_H3, ST_H4, ST_Q, ST_KV, ST_MEM };
constexpr int CW_TMO = 0, CW_CODE = 1, CW_BAR = 4096, CW_AFLAG = 16384; static_assert(CW_AFLAG == A_CW_AFLAG, "flag words");

constexpr int RING_BYTES = 131072, LDSCTL_OFF = RING_BYTES, MISC_OFF = LDSCTL_OFF + 320, LDS_BYTES = 147456;

typedef GAS unsigned gu32;
#define RLX_AGENT __ATOMIC_RELAXED, __HIP_MEMORY_SCOPE_AGENT
#define LDS_WAIT() asm volatile("s_waitcnt lgkmcnt(0)" ::: "memory")
#define VM_WAIT() asm volatile("s_waitcnt vmcnt(0)" ::: "memory")
__device__ __forceinline__ unsigned f2bf(float f) { unsigned u = __builtin_bit_cast(unsigned, f); return (u + 0x7fffu + ((u >> 16) & 1u)) >> 16; }
__device__ __forceinline__ unsigned pk2(float lo, float hi) { return f2bf(lo) | (f2bf(hi) << 16); }

#define XB_TMO      128
#define XB_XCNT(j)  (256  + 64 * (j))
#define XB_XSUB(j)  (1280 + 64 * (j))
#define XB_XGEN(j)  (2304 + 64 * (j))
#define XB_TOP      3328
#define XB_TOPGEN   3392
#define XCD_BAR_WORDS 3456
#define XB_SPIN_CAP (1u << 18)
__device__ __forceinline__ unsigned xb_ld(unsigned* p)              { return __hip_atomic_load(p, __ATOMIC_RELAXED, __HIP_MEMORY_SCOPE_AGENT); }
__device__ __forceinline__ unsigned xb_add(unsigned* p, unsigned v) { return __hip_atomic_fetch_add(p, v, __ATOMIC_RELAXED, __HIP_MEMORY_SCOPE_AGENT); }
__device__ __forceinline__ unsigned xb_xcc_id() { return (unsigned)__builtin_amdgcn_s_getreg((3 << 11) | 20) & 0xFu; }
#define XB_SPIN(cond, bar) do { unsigned _sp = 0; while (cond) { __builtin_amdgcn_s_sleep(1); \
    if ((++_sp & 255u) == 0u) { if (xb_ld(&(bar)[XB_TMO])) break; if (_sp > XB_SPIN_CAP) { atomicAdd(&(bar)[XB_TMO], 1u); break; } } } } while (0)
struct XcdBarrier { unsigned* bar; volatile LAS unsigned* st; int wave; };
__device__ __forceinline__ XcdBarrier xcd_barrier_post(unsigned* bar, volatile LAS unsigned* st) {
    XcdBarrier b; b.bar = bar; b.st = st; b.wave = 0;
    if (threadIdx.x == 0) (void)xb_add(&bar[XB_XCNT(xb_xcc_id())], 1u);
    return b;
}
__device__ __forceinline__ void xcd_barrier_complete(unsigned* bar, unsigned x, unsigned& nloc, unsigned& nx) {
    const unsigned G = GRID;
    unsigned sum, cnt, mine, sp = 0u;
    for (;;) {
        sum = 0u; cnt = 0u; mine = 0u;
#pragma unroll
        for (unsigned j = 0; j < 16; ++j) { const unsigned c = xb_ld(&bar[XB_XCNT(j)]); sum += c; cnt += (c > 0u) ? 1u : 0u; mine = (j == x) ? c : mine; }
        if (sum == G) break;
        __builtin_amdgcn_s_sleep(1);
        if ((++sp & 255u) == 0u) { if (xb_ld(&bar[XB_TMO])) break; if (sp > XB_SPIN_CAP) { atomicAdd(&bar[XB_TMO], 1u); break; } }
    }
    nloc = mine > 0u ? mine : 1u; nx = cnt > 0u ? cnt : 1u;
}
__device__ __forceinline__ void xcd_barrier(const XcdBarrier& b) {
    asm volatile("s_waitcnt vmcnt(0)" ::: "memory");
    __syncthreads();
    if (b.wave == 0 && lane_id() == 0) {
        unsigned* bar = b.bar; const unsigned bx_ = xb_xcc_id();
        __builtin_amdgcn_s_waitcnt(0);
        unsigned nloc = b.st[0], nx = b.st[1];
        if (nloc == 0u) { xcd_barrier_complete(bar, bx_, nloc, nx); b.st[0] = nloc; b.st[1] = nx; }
        const unsigned old = xb_add(&bar[XB_XSUB(bx_)], 1u);
        const unsigned gen = old / nloc;
        if (old + 1u == (gen + 1u) * nloc) {
            __builtin_amdgcn_fence(__ATOMIC_RELEASE, "agent");
            asm volatile("s_waitcnt vmcnt(0)" ::: "memory");
            const unsigned og = xb_add(&bar[XB_TOP], 1u);
            const unsigned tg = og / nx;
            if (og + 1u == (tg + 1u) * nx) xb_add(&bar[XB_TOPGEN], 1u);
            else XB_SPIN(xb_ld(&bar[XB_TOPGEN]) == tg, bar);
            __builtin_amdgcn_fence(__ATOMIC_ACQUIRE, "agent");
            xb_add(&bar[XB_XGEN(bx_)], 1u);
            asm volatile("s_waitcnt vmcnt(0)" ::: "memory");
        } else {
            XB_SPIN(xb_ld(&bar[XB_XGEN(bx_)]) == gen, bar);
            __builtin_amdgcn_fence(__ATOMIC_ACQUIRE, "agent");
            asm volatile("s_waitcnt vmcnt(0)" ::: "memory");
        }
    }
    __syncthreads();
}

__device__ __forceinline__ float wave_sum(float v) {
#pragma unroll
    for (int o = 1; o < 64; o <<= 1) v += __shfl_xor(v, o);
    return v;
}
template <class Src, class RowMap>
__device__ __forceinline__ void tr_item(const Src& S, const RowMap& R, bf16_t* dst, int dst_ld, int kcol0, int k0, int n0, LAS float* scr, int lane) {
    S.fill(scr, k0, n0, lane);
    LDS_WAIT(); asm volatile("" ::: "memory");
    const int c = lane & 7;
#pragma unroll
    for (int j = 0; j < 4; ++j) { const int n = (lane >> 3) + 8 * j; const LAS float* s = scr + (8 * c) * 33 + n;
        u32x4 o; o.x = pk2(s[0 * 33], s[1 * 33]); o.y = pk2(s[2 * 33], s[3 * 33]); o.z = pk2(s[4 * 33], s[5 * 33]); o.w = pk2(s[6 * 33], s[7 * 33]);
        *(GAS u32x4*)(dst + (size_t)R(n0 + n) * dst_ld + kcol0 + k0 + 8 * c) = o; }
    LDS_WAIT(); asm volatile("" ::: "memory");
}
struct SrcW {
    const float* W; int ldw; const float* gain;
    __device__ __forceinline__ void fill(LAS float* scr, int k0, int n0, int lane) const {
#pragma unroll 8
        for (int i = 0; i < 32; ++i) { const int kk = 2 * i + (lane >> 5); const float g = gain ? gain[k0 + kk] : 1.f; scr[kk * 33 + (lane & 31)] = W[(size_t)(k0 + kk) * ldw + n0 + (lane & 31)] * g; }
    }
};
struct RmOff { int off; __device__ __forceinline__ int operator()(int n) const { return off + n; } };
struct RmGate { int up; __device__ __forceinline__ int operator()(int n) const { return (n >> 7) * 256 + up * 128 + (n & 127); } };
struct RmWin { __device__ __forceinline__ int operator()(int n) const { return n < 448 ? n : n + 64; } };
struct RmQup { __device__ __forceinline__ int operator()(int n) const { const int h = n / 192, t = n - h * 192;
    if (t < 128) return (h >> 1) * 256 + (h & 1) * 128 + t; const int j = t - 128; return 512 + (j >> 5) * 128 + h * 32 + (j & 31); } };

struct Args { const float* in[26]; float* out; unsigned char* ws; int ph_lo, ph_hi; };
struct Frame { LAS unsigned char* lds; gu32* ctl; unsigned char* ws; int wave; };
__device__ __forceinline__ int vcu_of() { const int bx = blockIdx.x; return (bx % 8) * (GRID / 8) + bx / 8; }
__device__ __forceinline__ float* stat_ptr(unsigned char* ws, int which) { return (float*)(ws + WS_STAT + (size_t)which * STAT_BYTES); }

__device__ __forceinline__ void sincos_d(double a, double& s, double& c) {
    const double k = __builtin_rint(a * 0.63661977236758134308);
    const double r = __builtin_fma(-k, 1.2246467991473532e-16 * 0.5, __builtin_fma(-k, 1.5707963267948966, a));
    const int q = ((int)k) & 3;
    const double r2 = r * r;
    double sp = -7.6471637318198164759e-13; sp = sp * r2 + 1.6059043836821614599e-10; sp = sp * r2 - 2.5052108385441718775e-08; sp = sp * r2 + 2.7557319223985890653e-06;
    sp = sp * r2 - 1.9841269841269841270e-04; sp = sp * r2 + 8.3333333333333333333e-03; sp = sp * r2 - 1.6666666666666666667e-01; sp = sp * r2 * r + r;
    double cp = 4.7794773323873852974e-14; cp = cp * r2 - 1.1470745597729724714e-11; cp = cp * r2 + 2.0876756987868098979e-09; cp = cp * r2 - 2.7557319223985890653e-07;
    cp = cp * r2 + 2.4801587301587301587e-05; cp = cp * r2 - 1.3888888888888888889e-03; cp = cp * r2 + 4.1666666666666666667e-02; cp = cp * r2 - 0.5; cp = cp * r2 + 1.0;
    s = (q == 0) ? sp : (q == 1) ? cp : (q == 2) ? -sp : -cp;
    c = (q == 0) ? cp : (q == 1) ? -sp : (q == 2) ? -cp : sp;
}

__device__ __forceinline__ void p0_prologue(Frame& F, const Args& A) {
    LAS float* scr = (LAS float*)(F.lds + F.wave * 16384);
    int lane_ = lane_id(); asm volatile("" : "+v"(lane_));
    const int gw = vcu_of() * NWAVES + F.wave, NGW = GRID * NWAVES, lane = lane_;
    unsigned char* ws = F.ws;
    constexpr int I_PP = 8 * 32, I_FU = 16 * 88, I_FD = 44 * 32, I_IN = 16 * 30, I_QU = 4 * 24, I_KU = 2 * 32, I_WO = 8 * 32, I_MO = 16 * 32, I_MKV = 16 * 64;
    constexpr int NITEMS = I_PP + 4 * I_FU + 2 * I_FD + I_IN + I_QU + I_KU + I_WO + I_MO + I_MKV;
    for (int it = gw; it < NITEMS; it += NGW) {
        int r = it;
        if (r < I_PP) { SrcW S{A.in[15] + (size_t)512 * DM, DM, nullptr}; tr_item(S, RmOff{0}, (bf16_t*)(ws + WS_WOUTP), 512, 0, (r / 32) * 64, (r % 32) * 32, scr, lane); continue; } r -= I_PP;
        if (r < I_FU) { SrcW S{A.in[4], DFF, A.in[3]}; tr_item(S, RmGate{0}, (bf16_t*)(ws + WS_W1GU), DM, 0, (r / 88) * 64, (r % 88) * 32, scr, lane); continue; } r -= I_FU;
        if (r < I_FU) { SrcW S{A.in[5], DFF, A.in[3]}; tr_item(S, RmGate{1}, (bf16_t*)(ws + WS_W1GU), DM, 0, (r / 88) * 64, (r % 88) * 32, scr, lane); continue; } r -= I_FU;
        if (r < I_FU) { SrcW S{A.in[22], DFF, A.in[21]}; tr_item(S, RmGate{0}, (bf16_t*)(ws + WS_W2GU), DM, 0, (r / 88) * 64, (r % 88) * 32, scr, lane); continue; } r -= I_FU;
        if (r < I_FU) { SrcW S{A.in[23], DFF, A.in[21]}; tr_item(S, RmGate{1}, (bf16_t*)(ws + WS_W2GU), DM, 0, (r / 88) * 64, (r % 88) * 32, scr, lane); continue; } r -= I_FU;
        if (r < I_FD) { SrcW S{A.in[6], DM, nullptr}; tr_item(S, RmOff{0}, (bf16_t*)(ws + WS_W1D), DFF, 0, (r / 32) * 64, (r % 32) * 32, scr, lane); continue; } r -= I_FD;
        if (r < I_FD) { SrcW S{A.in[24], DM, nullptr}; tr_item(S, RmOff{0}, (bf16_t*)(ws + WS_W2D), DFF, 0, (r / 32) * 64, (r % 32) * 32, scr, lane); continue; } r -= I_FD;
        if (r < I_IN) { SrcW S{A.in[8], 960, A.in[7]}; tr_item(S, RmWin{}, (bf16_t*)(ws + WS_WIN), DM, 0, (r / 30) * 64, (r % 30) * 32, scr, lane); continue; } r -= I_IN;
        if (r < I_QU) { SrcW S{A.in[10], 768, A.in[9]}; tr_item(S, RmQup{}, (bf16_t*)(ws + WS_WQKV), 256, 0, (r / 24) * 64, (r % 24) * 32, scr, lane); continue; } r -= I_QU;
        if (r < I_KU) { SrcW S{A.in[12], 1024, A.in[11]}; tr_item(S, RmOff{768}, (bf16_t*)(ws + WS_WQKV), 256, 0, (r / 32) * 64, (r % 32) * 32, scr, lane); continue; } r -= I_KU;
        if (r < I_WO) { SrcW S{A.in[15], DM, nullptr}; tr_item(S, RmOff{0}, (bf16_t*)(ws + WS_WOUT), DM, 0, (r / 32) * 64, (r % 32) * 32, scr, lane); continue; } r -= I_WO;
        if (r < I_MO) { SrcW S{A.in[20], DM, nullptr}; tr_item(S, RmOff{0}, (bf16_t*)(ws + WS_WMOT), DM, 0, (r / 32) * 64, (r % 32) * 32, scr, lane); continue; } r -= I_MO;
        { SrcW S{A.in[19], 2048, A.in[17]}; tr_item(S, RmOff{0}, (bf16_t*)(ws + WS_WMKV), DM, 0, (r / 64) * 64, (r % 64) * 32, scr, lane); }
    }
    {
        const int gt = gw * 64 + lane, NT_ = NGW * 64;
        u32x4 z4 = {0u, 0u, 0u, 0u};
        for (int i = gt; i < 64 * 1024 / 8; i += NT_) *(GAS u32x4*)((bf16_t*)(ws + WS_WIN) + (size_t)448 * DM + (size_t)i * 8) = z4;
        for (int i = gt; i < 1024 * 16; i += NT_) { const int row = i >> 4, ch = i & 15; *(GAS u32x4*)((bf16_t*)(ws + WS_WQKV) + (size_t)(768 + row) * 256 + 128 + ch * 8) = z4; }
        for (int i = gt; i < 2 * 256 * 32; i += NT_) { const int pair = i >> 13, row = (i >> 5) & 255, ch = i & 31, gl = row >> 7, c = row & 127, g = 2 * pair + gl;
            u32x4 o = z4;
            if ((ch >> 4) == gl) { const int j0 = (ch & 15) * 8; const float* pw = A.in[13] + ((size_t)g * 128 + c) * 128 + j0; const float* ps = A.in[14] + g * 128 + j0;
                const f32x4 a = *(const f32x4*)pw * *(const f32x4*)ps, b = *(const f32x4*)(pw + 4) * *(const f32x4*)(ps + 4);
                o.x = pk2(a[0], a[1]); o.y = pk2(a[2], a[3]); o.z = pk2(b[0], b[1]); o.w = pk2(b[2], b[3]); }
            *(GAS u32x4*)((bf16_t*)(ws + WS_BTPOOL) + (size_t)i * 8) = o; }
        const float* wq = A.in[18]; const float* gq = A.in[16];
        for (int i = gt; i < DM * DM / 8; i += NT_) { const int k = i >> 7; const float g = gq[k];
            const f32x4 a = *(const f32x4*)(wq + (size_t)i * 8), b = *(const f32x4*)(wq + (size_t)i * 8 + 4);
            u32x4 o; o.x = pk2(a[0] * g, a[1] * g); o.y = pk2(a[2] * g, a[3] * g); o.z = pk2(b[0] * g, b[1] * g); o.w = pk2(b[2] * g, b[3] * g);
            *(GAS u32x4*)((bf16_t*)(ws + WS_WMQN) + (size_t)i * 8) = o; }
        const int* pos = (const int*)A.in[2];
        for (int i = gt; i < M * 32; i += NT_) { const int m = i >> 5, j = i & 31;
            double pd_ = 1.0; for (int q = 0; q < j; ++q) pd_ *= 1.3335214321633240257;
            const float fr = 1.0f / (float)pd_;
            const float ang = (float)pos[m] * fr;
            double s, c; sincos_d((double)ang, s, c);
            ((float*)(ws + WS_COS))[i] = (float)c; ((float*)(ws + WS_SIN))[i] = (float)s; }
    }
    for (int m = gw; m < M + 1024; m += NGW) {
        const bool isx = m < M; const int row = isx ? m : m - M;
        const float* src = (isx ? A.in[0] : A.in[1]) + (size_t)row * DM;
        bf16_t* dst = (bf16_t*)(ws + (isx ? WS_HB : WS_MEMB)) + (size_t)row * DM;
        const GAS f32x4* xr = (const GAS f32x4*)src + lane;
        f32x4 v[4]; float s = 0.f;
#pragma unroll
        for (int j = 0; j < 4; ++j) { v[j] = xr[64 * j]; s += (v[j].x * v[j].x + v[j].y * v[j].y) + (v[j].z * v[j].z + v[j].w * v[j].w); }
        s = wave_sum(s);
        GAS unsigned long long* o8 = (GAS unsigned long long*)dst + lane;
#pragma unroll
        for (int j = 0; j < 4; ++j) o8[64 * j] = (unsigned long long)pk2(v[j].x, v[j].y) | ((unsigned long long)pk2(v[j].z, v[j].w) << 32);
        if (lane < 4) { float* st = stat_ptr(ws, isx ? ST_X : ST_MEM); const int sm = isx ? M : 1024; st[lane * sm + row] = (lane == 0) ? s : 0.f; }
    }
}

__device__ __forceinline__ void mix_prep(Frame& F) {
    const int gw = vcu_of() * NWAVES + F.wave, NGW = GRID * NWAVES; int lane_ = lane_id(); asm volatile("" : "+v"(lane_)); const int lane = lane_;
    const bf16_t* zb = (const bf16_t*)(F.ws + WS_ZB); bf16_t* a2 = (bf16_t*)(F.ws + WS_A2); bf16_t* kpe = (bf16_t*)(F.ws + WS_KPE);
    const float* cosT = (const float*)(F.ws + WS_COS); const float* sinT = (const float*)(F.ws + WS_SIN);
    const int g = lane >> 4, w = 2 << g, c8 = (lane & 15) * 8;
    for (int run = gw; run < M / 8; run += NGW) {
        const int m0 = run * 8, s0 = m0 & (SEQ - 1);
        const bf16_t* zp = zb + 512 + g * 128 + c8;
        bf16x8 zr[23];
#pragma unroll
        for (int i = 0; i < 23; ++i) { const int d = 15 - i;
            zr[i] = (bf16x8){0, 0, 0, 0, 0, 0, 0, 0};
            if (d <= 0 || (d < w && s0 - d >= 0)) zr[i] = *(const bf16x8*)(zp + (size_t)(m0 - d) * DM); }
#pragma unroll
        for (int r = 0; r < 8; ++r) {
            const int s = s0 + r;
            float sum[8];
#pragma unroll
            for (int i = 0; i < 8; ++i) sum[i] = 0.f;
#pragma unroll
            for (int d = 0; d < 16; ++d) { if (d < w) {
#pragma unroll
                for (int i = 0; i < 8; ++i) sum[i] += bf2f((unsigned short)zr[15 + r - d][i]); } }
            const float inv = 1.0f / (float)((s + 1 < w) ? (s + 1) : w);
            float zf[8];
#pragma unroll
            for (int i = 0; i < 8; ++i) zf[i] = bf2f((unsigned short)zr[15 + r][i]);
            u32x4 o; o.x = cvt_pk_bf16(sum[0] * inv - zf[0], sum[1] * inv - zf[1]); o.y = cvt_pk_bf16(sum[2] * inv - zf[2], sum[3] * inv - zf[3]);
            o.z = cvt_pk_bf16(sum[4] * inv - zf[4], sum[5] * inv - zf[5]); o.w = cvt_pk_bf16(sum[6] * inv - zf[6], sum[7] * inv - zf[7]);
            *(u32x4*)(a2 + (size_t)(m0 + r) * DM + 512 + g * 128 + c8) = o;
        }
#pragma unroll
        for (int rr = 0; rr < 4; ++rr) { const int m = m0 + 2 * rr + (lane >> 5), j = lane & 31;
            const float x1 = bf2f(zb[(size_t)m * DM + 384 + j]), x2 = bf2f(zb[(size_t)m * DM + 416 + j]);
            const float c = cosT[(size_t)m * 32 + j], sn = sinT[(size_t)m * 32 + j];
            kpe[(size_t)m * 64 + j] = (bf16_t)f2bf(x1 * c - x2 * sn); kpe[(size_t)m * 64 + 32 + j] = (bf16_t)f2bf(x1 * sn + x2 * c); }
    }
}
__device__ __forceinline__ void final_norm(Frame& F, const Args& A) {
    int lane_ = lane_id(); asm volatile("" : "+v"(lane_));
    const int gw = vcu_of() * NWAVES + F.wave, NGW = GRID * NWAVES, lane = lane_;
    const float* st = stat_ptr(F.ws, ST_H4); const float* g = A.in[25];
    f32x4 gv[4];
#pragma unroll
    for (int j = 0; j < 4; ++j) gv[j] = *(const f32x4*)(g + 4 * lane + 256 * j);
    for (int m = gw; m < M; m += NGW) {
        const float sc = pg8::rstd_of(st, m, 1.0f / DM);
        GAS f32x4* xr = (GAS f32x4*)(A.out + (size_t)m * DM) + lane;
#pragma unroll
        for (int j = 0; j < 4; ++j) { f32x4 v = xr[64 * j]; v = v * sc * gv[j]; xr[64 * j] = v; }
    }
}

struct GridOrder {
    int nM, nN, G, c; const char* A; const char* B; size_t sa_pm; size_t sb_pn; int a_thr; size_t a_off; int b_shift; size_t sb_b;
    __device__ __forceinline__ bool next(int i, pg8::Unit& u) const {
        int pm, pn; if (!pg8::tile_of(i * G + c, nM, nN, pm, pn)) return false;
        u.pm = pm; u.pn = pn; u.a = A + (size_t)pm * sa_pm + (pn >= a_thr ? a_off : 0); u.b = B + (size_t)pn * sb_pn + (size_t)(pm >> b_shift) * sb_b; u.o = nullptr; return true;
    }
};
struct MemKVOrder {
    int G, c; unsigned char* ws;
    __device__ __forceinline__ bool next(int i, pg8::Unit& u) const {
        const int L = i * G + c; if (L >= 32) return false;
        const int b = L >> 3, pn = L & 7, kv = pn >> 2, h = pn & 3;
        u.pm = b; u.pn = pn; u.a = (const char*)(ws + WS_MEMB) + (size_t)b * 256 * DM * 2; u.b = (const char*)(ws + WS_WMKV) + (size_t)pn * 256 * DM * 2;
        u.o = (char*)(ws + (kv ? WS_VM : WS_KM)) + (size_t)(b * 4 + h) * 256 * 256 * 2; return true;
    }
};
struct WeffOrder {
    int G, c; unsigned char* ws;
    __device__ __forceinline__ bool next(int i, pg8::Unit& u) const {
        const int L = i * G + c; if (L >= 64) return false;
        const int bh = L >> 2, pn = L & 3, b = bh >> 2, h = bh & 3;
        u.pm = 0; u.pn = pn; u.a = (const char*)(ws + WS_KM) + (size_t)bh * 256 * 256 * 2; u.b = (const char*)(ws + WS_WMQN) + ((size_t)pn * 256 * DM + h * 256) * 2;
        u.o = (char*)(ws + WS_WEFF) + (((size_t)b * 1024 + h * 256) * 1024 + pn * 256) * 2; return true;
    }
};
struct WvoOrder {
    int G, c; unsigned char* ws;
    __device__ __forceinline__ bool next(int i, pg8::Unit& u) const {
        const int L = i * G + c; if (L >= 64) return false;
        const int bh = L >> 2, pm = L & 3, b = bh >> 2, h = bh & 3;
        u.pm = 0; u.pn = 0; u.a = (const char*)(ws + WS_WMOT) + ((size_t)pm * 256 * DM + h * 256) * 2; u.b = (const char*)(ws + WS_VM) + (size_t)bh * 256 * 256 * 2;
        u.o = (char*)(ws + WS_WVO) + (((size_t)b * 1024 + pm * 256) * 1024 + h * 256) * 2; return true;
    }
};

struct WppOrder {
    int G, c; unsigned char* ws;
    __device__ __forceinline__ bool next(int i, pg8::Unit& u) const {
        const int L = i * G + c; if (L >= 8) return false;
        const int pm = L >> 1, pair = L & 1;
        u.pm = 0; u.pn = 0; u.a = (const char*)(ws + WS_WOUTP) + ((size_t)pm * 256 * 512 + pair * 256) * 2; u.b = (const char*)(ws + WS_BTPOOL) + (size_t)pair * 256 * 256 * 2;
        u.o = (char*)(ws + WS_WOUT) + ((size_t)pm * 256 * DM + 512 + pair * 256) * 2; return true;
    }
};

__global__ void __launch_bounds__(NWAVES * 64, 2) mk_fwd(Args args) {
    extern __shared__ __attribute__((aligned(16))) unsigned char lds[];
    Frame F;
    F.lds = (LAS unsigned char*)lds;
    F.wave = __builtin_amdgcn_readfirstlane((int)threadIdx.x >> 6);
    unsigned char* ws = args.ws; F.ws = ws;
    F.ctl = (gu32*)(ws + WS_CTL);
    for (int u = threadIdx.x; u < (LDS_BYTES - LDSCTL_OFF) / 4; u += NWAVES * 64) ((LAS unsigned*)(F.lds + LDSCTL_OFF))[u] = 0u;
    __syncthreads();
    XcdBarrier bar; bar.bar = (unsigned*)(F.ctl + CW_BAR); bar.st = (volatile LAS unsigned*)(F.lds + MISC_OFF) + 8; bar.wave = F.wave;
    if (!MK_PER_PHASE) { (void)xcd_barrier_post((unsigned*)(F.ctl + CW_BAR), bar.st); }
#define GRID_BAR() do { if (MK_PER_PHASE) { if (F.wave == 0 && lane_id() == 0) __hip_atomic_store(F.ctl + CW_TMO, 0xBADBA0u, RLX_AGENT); } else { xcd_barrier(bar); } } while (0)
    const int lo = args.ph_lo, hi = args.ph_hi;
#ifndef PH_MASK
#define PH_MASK 0xFFFF
#endif
#define IN(k) (lo <= (k) && (k) < hi && ((PH_MASK >> (k)) & 1))
#define BOTH(k) (IN(k) && IN((k) + 1))
    constexpr int G = GRID; const int c = (int)blockIdx.x;
#define HBp ((const char*)(ws + WS_HB))
    using namespace pg8;

    if (IN(0)) { p0_prologue(F, args); if (BOTH(0)) GRID_BAR(); }

    if (IN(1)) {
#ifndef P1_SUB
#define P1_SUB 7
#endif
        if (P1_SUB & 1) { Gemm g{DM, DM, DM}; GridOrder S{64, 22, G, c, HBp, (const char*)(ws + WS_W1GU), (size_t)256 * DM * 2, (size_t)256 * DM * 2, 1 << 30, 0, 30, 0};
          EpiSwiGLU E{stat_ptr(ws, ST_X), (bf16_t*)(ws + WS_ACT)};
          gemm_phase<EpiSwiGLU, GridOrder, true>(F.lds, F.wave, g, S, E); }
        if (P1_SUB & 2) { Gemm g{DM, DM, DM}; MemKVOrder S{G, (c + G - 128) % G, ws}; EpiStore E{stat_ptr(ws, ST_MEM), 1.0f / DM, 256, 1024};
          gemm_phase<EpiStore, MemKVOrder, true>(F.lds, F.wave, g, S, E); }
        if (P1_SUB & 4) { Gemm g{512, 256, 256}; WppOrder S{G, (c + G - 160) % G, ws}; EpiStore E{nullptr, 0.f, 1024, 0};
          gemm_phase<EpiStore, WppOrder, true>(F.lds, F.wave, g, S, E); }
        if (BOTH(1)) GRID_BAR();
    }
    if (IN(2)) {
        Gemm g{DFF, DFF, DFF}; GridOrder S{64, 4, G, c, (const char*)(ws + WS_ACT), (const char*)(ws + WS_W1D), (size_t)256 * DFF * 2, (size_t)256 * DFF * 2, 1 << 30, 0, 30, 0};
        EpiResid E{args.in[0], args.out, (bf16_t*)(ws + WS_HB), stat_ptr(ws, ST_H1), 0.5f};
        gemm_phase<EpiResid, GridOrder, false>(F.lds, F.wave, g, S, E);
        if (BOTH(2)) GRID_BAR();
    }
    if (IN(3)) {
        Gemm g{DM, DM, DM}; GridOrder S{64, 4, G, c, HBp, (const char*)(ws + WS_WIN), (size_t)256 * DM * 2, (size_t)256 * DM * 2, 1 << 30, 0, 30, 0};
        EpiZ E{stat_ptr(ws, ST_H1), (bf16_t*)(ws + WS_ZB), stat_ptr(ws, ST_Q), stat_ptr(ws, ST_KV)};
        gemm_phase<EpiZ, GridOrder, true>(F.lds, F.wave, g, S, E);
        if (BOTH(3)) GRID_BAR();
    }
    if (IN(4)) {
#ifndef P4_SUB
#define P4_SUB 15
#endif
        if (P4_SUB & 1) mix_prep(F);
        if (P4_SUB & 2) { Gemm g{DM, 256, 256}; GridOrder S{64, 7, G, c, (const char*)(ws + WS_ZB), (const char*)(ws + WS_WQKV), (size_t)256 * DM * 2, (size_t)256 * 256 * 2, 3, 256 * 2, 30, 0};
          EpiQKV E{stat_ptr(ws, ST_Q), stat_ptr(ws, ST_KV), (const float*)(ws + WS_COS), (const float*)(ws + WS_SIN), (bf16_t*)(ws + WS_Q), (bf16_t*)(ws + WS_KN), (bf16_t*)(ws + WS_V), 0.07216878364870322f * LOG2E};
          gemm_phase<EpiQKV, GridOrder, true>(F.lds, F.wave, g, S, E); }
        if (P4_SUB & 4) { Gemm g{256, DM, 256}; WeffOrder S{G, (c + G - 192) % G, ws}; EpiStore E{nullptr, 0.f, 1024, 0};
          gemm_phase<EpiStore, WeffOrder, true>(F.lds, F.wave, g, S, E); }
        if (P4_SUB & 8) { Gemm g{DM, 256, 256}; WvoOrder S{G, (c + G - 192) % G, ws}; EpiStore E{nullptr, 0.f, 1024, 0};
          gemm_phase<EpiStore, WvoOrder, true>(F.lds, F.wave, g, S, E); }
        if (BOTH(4)) GRID_BAR();
    }
    if (IN(5)) {
        const int vcu = vcu_of(), bh = vcu >> 4, idx = vcu & 15, x = idx >> 1, role = idx & 1, pairid = bh * 8 + x;
        {
            attn::Blk B; B.ws = ws; B.ctl = (unsigned*)F.ctl; B.bh = bh; B.pairid = pairid;
            if (role == 0) {
                B.qb = 15 - x; B.j_lo = 0; B.j_hi = 30 - 4 * x; attn::block<1>(B, F.wave, (char*)lds);
                B.qb = x; B.j_lo = 0; B.j_hi = 4 * (x + 1); attn::block<0>(B, F.wave, (char*)lds);
            } else { B.qb = 15 - x; B.j_lo = 30 - 4 * x; B.j_hi = 4 * (16 - x); attn::block<2>(B, F.wave, (char*)lds); }
        }
        if (BOTH(5)) GRID_BAR();
    }
    if (IN(6)) {
        Gemm g{DM, DM, DM}; GridOrder S{64, 4, G, c, (const char*)(ws + WS_A2), (const char*)(ws + WS_WOUT), (size_t)256 * DM * 2, (size_t)256 * DM * 2, 1 << 30, 0, 30, 0};
        EpiResid E{args.out, args.out, (bf16_t*)(ws + WS_HB), stat_ptr(ws, ST_H2), 1.0f};
        gemm_phase<EpiResid, GridOrder, false>(F.lds, F.wave, g, S, E);
        if (BOTH(6)) GRID_BAR();
    }
    if (IN(7)) {
        Gemm g{DM, DM, DM}; GridOrder S{64, 4, G, c, HBp, (const char*)(ws + WS_WEFF), (size_t)256 * DM * 2, (size_t)256 * DM * 2, 1 << 30, 0, 4, (size_t)DM * DM * 2};
        EpiSoftmax E{stat_ptr(ws, ST_H2), (bf16_t*)(ws + WS_ZB), 0.0625f * LOG2E};
        gemm_phase<EpiSoftmax, GridOrder, false>(F.lds, F.wave, g, S, E);
        if (BOTH(7)) GRID_BAR();
    }
    if (IN(8)) {
        Gemm g{DM, DM, DM}; GridOrder S{64, 4, G, c, (const char*)(ws + WS_ZB), (const char*)(ws + WS_WVO), (size_t)256 * DM * 2, (size_t)256 * DM * 2, 1 << 30, 0, 4, (size_t)DM * DM * 2};
        EpiResid E{args.out, args.out, (bf16_t*)(ws + WS_HB), stat_ptr(ws, ST_H3), 1.0f};
        gemm_phase<EpiResid, GridOrder, false>(F.lds, F.wave, g, S, E);
        if (BOTH(8)) GRID_BAR();
    }
    if (IN(9)) {
        Gemm g{DM, DM, DM}; GridOrder S{64, 22, G, c, HBp, (const char*)(ws + WS_W2GU), (size_t)256 * DM * 2, (size_t)256 * DM * 2, 1 << 30, 0, 30, 0};
        EpiSwiGLU E{stat_ptr(ws, ST_H3), (bf16_t*)(ws + WS_ACT)};
        gemm_phase<EpiSwiGLU, GridOrder, true>(F.lds, F.wave, g, S, E);
        if (BOTH(9)) GRID_BAR();
    }
    if (IN(10)) {
        Gemm g{DFF, DFF, DFF}; GridOrder S{64, 4, G, c, (const char*)(ws + WS_ACT), (const char*)(ws + WS_W2D), (size_t)256 * DFF * 2, (size_t)256 * DFF * 2, 1 << 30, 0, 30, 0};
        EpiResid E{args.out, args.out, nullptr, stat_ptr(ws, ST_H4), 0.5f};
        gemm_phase<EpiResid, GridOrder, false>(F.lds, F.wave, g, S, E);
        if (BOTH(10)) GRID_BAR();
    }
    if (IN(11)) { final_norm(F, args); }
#undef IN
#undef BOTH
#undef GRID_BAR
#undef HBp
}

extern "C" void kernel_launch(void* const* d_in, const int* in_sizes, int n_in, void* d_out, int out_size, void* d_ws, size_t ws_size, hipStream_t stream) {
    static int grid = 0;
    if (grid == 0) {
        if (n_in != 26 || in_sizes[0] != M * DM || out_size != M * DM || ws_size < WS_END) {
            fprintf(stderr, "kernel_launch: unexpected shapes: n_in %d, in0 %d, out %d, ws %zu (need >= %zu); nothing launched\n", n_in, n_in > 0 ? in_sizes[0] : -1, out_size, ws_size, (size_t)WS_END); grid = -1; return; }
        int dev = 0, cus = 0;
        if (hipGetDevice(&dev) != hipSuccess || hipDeviceGetAttribute(&cus, hipDeviceAttributeMultiprocessorCount, dev) != hipSuccess) { fprintf(stderr, "kernel_launch: device query failed\n"); grid = -1; return; }
        if (hipFuncSetAttribute((const void*)mk_fwd, hipFuncAttributeMaxDynamicSharedMemorySize, LDS_BYTES) != hipSuccess) { fprintf(stderr, "kernel_launch: hipFuncSetAttribute failed\n"); grid = -1; return; }
        (void)hipGetLastError();
        grid = GRID;
        if (cus < GRID) { fprintf(stderr, "kernel_launch: %d CUs, this kernel needs %d; nothing launched\n", cus, GRID); grid = -1; return; }
    }
    if (grid < 0) return;
    if (hipMemsetAsync((char*)d_ws + WS_CTL, 0, CTL_ZERO_BYTES, stream) != hipSuccess) { fprintf(stderr, "kernel_launch: memset failed\n"); return; }
    Args a{};
    for (int i = 0; i < 26; ++i) a.in[i] = (const float*)d_in[i];
    a.out = (float*)d_out; a.ws = (unsigned char*)d_ws;
#if MK_PER_PHASE
#ifndef PH_SEQ
#define PH_SEQ {0, 1, 2, 3, 4, 5, 6, 7, 8, 9, 10, 11}
#endif
    static const int seq[] = PH_SEQ;
    for (int p : seq) { a.ph_lo = p; a.ph_hi = p + 1; hipLaunchKernelGGL(mk_fwd, dim3(grid), dim3(NWAVES * 64), LDS_BYTES, stream, a); }
#else
    a.ph_lo = 0; a.ph_hi = N_PHASES;
    hipLaunchKernelGGL(mk_fwd, dim3(grid), dim3(NWAVES * 64), LDS_BYTES, stream, a);
#endif
    const hipError_t le = hipPeekAtLastError();
    if (le != hipSuccess) fprintf(stderr, "kernel_launch: launch failed: %s\n", hipGetErrorName(le));
}
```
